# Optimizing an MI355X kernel written in HIP

```python
import jax
import jax.numpy as jnp
from jax import lax
import numpy as np

D_MODEL = 1024
BATCH = 4
SEQ = 4096
DEPTH = 4

GRID_W = 64
CTX_LEN = 256

BRANCH_WIDTH = 512
NA_HEADS = 8
NA_HEAD_DIM = 64
NA_WIDTH = NA_HEADS * NA_HEAD_DIM
NA_WIN_H = 8
NA_WIN_W = 16
RWKV_HEADS = 8
RWKV_HEAD_DIM = 64
RWKV_WIDTH = RWKV_HEADS * RWKV_HEAD_DIM
DECAY_LORA = 64
AAA_LORA = 64
GATE_LORA = 128
RWKV_IN = 3 * RWKV_WIDTH + 2 * DECAY_LORA + 2 * AAA_LORA + GATE_LORA
RWKV_GN_EPS = 64e-5
SGU_GROUPS = 8
SGU_WIDTH = 512
SGU_CHUNK = 128
SGU_IN = 2 * SGU_WIDTH
N_BRANCH = 3
D_FF = -(-8 * D_MODEL // (3 * 256)) * 256
LN_EPS = 1e-5
ALPHA = (2 * DEPTH) ** 0.25
BETA = (8 * DEPTH) ** -0.25

_IN_SIZES = (N_BRANCH * D_MODEL, NA_WIDTH, NA_WIDTH, NA_WIDTH, RWKV_IN, SGU_IN)
IN_SPLITS = tuple(int(s) for s in np.cumsum(_IN_SIZES)[:-1])
D_IN = int(sum(_IN_SIZES))
_RWKV_SIZES = (RWKV_WIDTH, RWKV_WIDTH, RWKV_WIDTH, 2 * DECAY_LORA, 2 * AAA_LORA, GATE_LORA)
RWKV_SPLITS = tuple(int(s) for s in np.cumsum(_RWKV_SIZES)[:-1])

kernel_name = 'hybrid_na_rwkv7_gmlp_deepnorm_block'


def layer_norm(x, g, b, eps=LN_EPS):
    xf = x.astype(jnp.float32)
    mu = jnp.mean(xf, axis=-1, keepdims=True)
    var = jnp.mean(jnp.square(xf - mu), axis=-1, keepdims=True)
    return ((xf - mu) * lax.rsqrt(var + eps) * g + b).astype(x.dtype)


def _heads(t):
    return t.reshape(t.shape[0], t.shape[1], NA_HEADS, NA_HEAD_DIM)


def neighbourhood_attention(q, k, v, kc, vc, rpb):
    B, S, H, Dh = q.shape
    rows = S // GRID_W
    wh = min(NA_WIN_H, rows)
    n_loc = wh * NA_WIN_W
    scale = Dh ** -0.5
    qg = q.reshape(B, rows, GRID_W, H, Dh)
    kg = k.reshape(B, rows, GRID_W, H, Dh)
    vg = v.reshape(B, rows, GRID_W, H, Dh)
    row0 = jnp.clip(jnp.arange(rows) - wh // 2, 0, rows - wh)
    cols = jnp.arange(GRID_W)
    key_cols = jnp.clip(cols - NA_WIN_W // 2, 0, GRID_W - NA_WIN_W)[:, None] + jnp.arange(NA_WIN_W)
    bias_c = rpb[:, :, key_cols - cols[:, None] + NA_WIN_W - 1]

    def row_block(r):
        key_rows = row0[r] + jnp.arange(wh)
        kb = jnp.take(kg, key_rows, axis=1)[:, :, key_cols]
        vb = jnp.take(vg, key_rows, axis=1)[:, :, key_cols]
        qb = lax.dynamic_index_in_dim(qg, r, axis=1, keepdims=False)
        bias = jnp.take(bias_c, key_rows - r + NA_WIN_H - 1, axis=1)
        s_loc = jnp.einsum('bchd,bicjhd->bhcij', qb, kb) * scale + jnp.transpose(bias, (0, 2, 1, 3))
        s_ctx = jnp.einsum('bchd,blhd->bhcl', qb, kc) * scale
        s = jnp.concatenate([s_loc.reshape(B, H, GRID_W, n_loc).astype(jnp.float32),
                             s_ctx.astype(jnp.float32)], axis=-1)
        p = jax.nn.softmax(s, axis=-1).astype(v.dtype)
        p_loc = p[..., :n_loc].reshape(B, H, GRID_W, wh, NA_WIN_W)
        return (jnp.einsum('bhcij,bicjhd->bchd', p_loc, vb)
                + jnp.einsum('bhcl,blhd->bchd', p[..., n_loc:], vc))

    out = lax.map(row_block, jnp.arange(rows))
    return jnp.transpose(out, (1, 0, 2, 3, 4)).reshape(B, S, H * Dh)


def context_attention(qc, kc, vc):
    s = jnp.einsum('blhd,bmhd->bhlm', qc, kc) * qc.shape[-1] ** -0.5
    p = jax.nn.softmax(s.astype(jnp.float32), axis=-1).astype(vc.dtype)
    return jnp.einsum('bhlm,bmhd->blhd', p, vc).reshape(qc.shape[0], qc.shape[1], -1)


def centred_shift(p, mu_prev, mu_next):
    zero = jnp.zeros_like(p[:, :1])
    prev = jnp.concatenate([zero, p[:, :-1]], axis=1)
    nxt = jnp.concatenate([p[:, 1:], zero], axis=1)
    return p + mu_prev * (prev - p) + mu_next * (nxt - p)


def _dir_time_major(t):
    B, T, _, _ = t.shape
    t = jnp.stack([t[:, :, 0], jnp.flip(t[:, :, 1], axis=1)], axis=0)
    return jnp.transpose(t.reshape(2, B, T, RWKV_HEADS, RWKV_HEAD_DIM), (2, 0, 1, 3, 4))


def rwkv_prep(p, mu_prev, mu_next, w0, w2, a0, a2, g2, k_k, k_a):
    f32 = jnp.float32
    p = centred_shift(p, mu_prev, mu_next)
    r, k, v, wc, ac, gc = jnp.split(p, RWKV_SPLITS, axis=-1)
    B, T, C = r.shape
    wc = wc.reshape(B, T, 2, DECAY_LORA)
    ac = ac.reshape(B, T, 2, AAA_LORA)
    w_log = -jax.nn.softplus(-(w0 + jnp.einsum('btdr,drc->btdc', jnp.tanh(wc), w2)).astype(f32)) - 0.5
    decay = jnp.exp(-jnp.exp(w_log))
    a = jax.nn.sigmoid((a0 + jnp.einsum('btdr,drc->btdc', ac, a2)).astype(f32))
    g = jax.nn.sigmoid(gc) @ g2
    kk = (k * k_k).astype(f32).reshape(B, T, RWKV_HEADS, RWKV_HEAD_DIM)
    kk = (kk * lax.rsqrt(jnp.sum(kk * kk, axis=-1, keepdims=True) + 1e-12)).reshape(B, T, C)
    kd = k.astype(f32)[:, :, None] * (1.0 + (a - 1.0) * k_a)
    shape = kd.shape
    rd = jnp.broadcast_to(r.astype(f32)[:, :, None], shape)
    vd = jnp.broadcast_to(v.astype(f32)[:, :, None], shape)
    kkd = jnp.broadcast_to(kk[:, :, None], shape)
    scan_in = (_dir_time_major(rd), _dir_time_major(decay), _dir_time_major(kd),
               _dir_time_major(vd), _dir_time_major(kkd), _dir_time_major(a))
    return scan_in, (r, kd, v, g)


def delta_scan(state0, inputs, emit):
    def step(S, inp):
        r_t, w_t, k_t, v_t, kk_t, a_t = inp
        s_kk = jnp.einsum('...vk,...k->...v', S, kk_t)
        S = (S * w_t[..., None, :] - s_kk[..., :, None] * (kk_t * a_t)[..., None, :]
             + v_t[..., :, None] * k_t[..., None, :])
        return S, (jnp.einsum('...vk,...k->...v', S, r_t) if emit else None)
    return lax.scan(step, state0, inputs)


def rwkv_readout(ys, r, kd, v, g, r_k, gn_g, gn_b):
    B, T, C = r.shape
    H, N = RWKV_HEADS, RWKV_HEAD_DIM
    y = jnp.transpose(ys[:, 0] + jnp.flip(ys[:, 1], axis=0), (1, 0, 2, 3))
    mu = jnp.mean(y, axis=-1, keepdims=True)
    var = jnp.mean(jnp.square(y - mu), axis=-1, keepdims=True)
    y = (y - mu) * lax.rsqrt(var + RWKV_GN_EPS) * gn_g.reshape(H, N) + gn_b.reshape(H, N)
    bonus = jnp.sum(r.astype(jnp.float32).reshape(B, T, 1, H, N) * kd.reshape(B, T, 2, H, N) * r_k,
                    axis=(2, 4))
    y = y + bonus[..., None] * v.reshape(B, T, H, N)
    return (y.reshape(B, T, C) * g).astype(r.dtype)


def spatial_gating(p, ln_g, ln_b, w_s, b_s):
    u, v = jnp.split(jax.nn.gelu(p), 2, axis=-1)
    v = layer_norm(v, ln_g, ln_b)
    B, T, C = v.shape
    vc = v.reshape(B, T // SGU_CHUNK, SGU_CHUNK, SGU_GROUPS, C // SGU_GROUPS)
    vm = jnp.einsum('gpq,bnqgc->bnpgc', w_s, vc) + jnp.transpose(b_s)[:, :, None]
    return u * vm.reshape(B, T, C)


def merge_branches(gates, o_na, o_rwkv, o_sgu, w_branch, w_out):
    g_na, g_rwkv, g_sgu = jnp.split(jax.nn.sigmoid(gates), N_BRANCH, axis=-1)
    y = g_na * (o_na @ w_branch[0]) + g_rwkv * (o_rwkv @ w_branch[1]) + g_sgu * (o_sgu @ w_branch[2])
    return y @ w_out


def token_mixer(h, hc, w_in, rpb, mu_prev, mu_next, w0, w2, a0, a2, g2, k_k, k_a, r_k, gn_g, gn_b,
                sgu_ln_g, sgu_ln_b, sgu_w, sgu_b, w_branch, w_out, ctx_out):
    B = h.shape[0]
    gates, q, k, v, p_rwkv, p_sgu = jnp.split(h @ w_in, IN_SPLITS, axis=-1)
    gates_c, q_c, k_c, v_c, p_rwkv_c, p_sgu_c = jnp.split(hc @ w_in, IN_SPLITS, axis=-1)
    kc_h, vc_h = _heads(k_c), _heads(v_c)
    o_na = neighbourhood_attention(_heads(q), _heads(k), _heads(v), kc_h, vc_h, rpb)
    rw = (mu_prev, mu_next, w0, w2, a0, a2, g2, k_k, k_a)
    scan_c, read_c = rwkv_prep(p_rwkv_c, *rw)
    scan_l, read_l = rwkv_prep(p_rwkv, *rw)
    state0 = jnp.zeros((2, B, RWKV_HEADS, RWKV_HEAD_DIM, RWKV_HEAD_DIM), jnp.float32)
    state_ctx, ys_c = delta_scan(state0, scan_c, ctx_out)
    _, ys_l = delta_scan(state_ctx, scan_l, True)
    o_rwkv = rwkv_readout(ys_l, *read_l, r_k, gn_g, gn_b)
    o_sgu = spatial_gating(p_sgu, sgu_ln_g, sgu_ln_b, sgu_w, sgu_b)
    y = merge_branches(gates, o_na, o_rwkv, o_sgu, w_branch, w_out)
    if not ctx_out:
        return y, None
    o_na_c = context_attention(_heads(q_c), kc_h, vc_h)
    o_rwkv_c = rwkv_readout(ys_c, *read_c, r_k, gn_g, gn_b)
    o_sgu_c = spatial_gating(p_sgu_c, sgu_ln_g, sgu_ln_b, sgu_w, sgu_b)
    y_c = merge_branches(gates_c, o_na_c, o_rwkv_c, o_sgu_c, w_branch, w_out)
    return y, y_c


def swiglu(h, w_gu, w_down):
    gate, up = jnp.split(h @ w_gu, 2, axis=-1)
    return (jax.nn.silu(gate) * up) @ w_down


def setup_inputs(seed: int = 0) -> dict:
    key = jax.random.key(seed)
    ks = iter(jax.random.split(key, 32))
    L, D, W = DEPTH, D_MODEL, BRANCH_WIDTH

    def nrm(shape, s):
        return s * jax.random.normal(next(ks), shape, jnp.float32)

    def uni(shape, lo, hi):
        return jax.random.uniform(next(ks), shape, jnp.float32, minval=lo, maxval=hi)

    return {
        'x': nrm((BATCH, SEQ, D), 1.0),
        'c': nrm((BATCH, D), 1.0),
        'ctx': nrm((BATCH, CTX_LEN, D), 1.0),
        'c_ctx': nrm((D,), 1.0),
        'w_ada': nrm((L, D, 6 * D), 0.5 * D ** -0.5),
        'b_ada': nrm((L, 6 * D), 0.02),
        'w_in': nrm((L, D, D_IN), D ** -0.5),
        'na_rpb': nrm((L, NA_HEADS, 2 * NA_WIN_H - 1, 2 * NA_WIN_W - 1), 0.5),
        'rwkv_mu_prev': uni((L, RWKV_IN), 0.0, 0.5),
        'rwkv_mu_next': uni((L, RWKV_IN), 0.0, 0.5),
        'rwkv_w0': uni((L, 2, RWKV_WIDTH), -6.0, 1.0),
        'rwkv_w2': nrm((L, 2, DECAY_LORA, RWKV_WIDTH), 0.5 * DECAY_LORA ** -0.5),
        'rwkv_a0': nrm((L, 2, RWKV_WIDTH), 0.1),
        'rwkv_a2': nrm((L, 2, AAA_LORA, RWKV_WIDTH), 0.5 * AAA_LORA ** -0.5),
        'rwkv_g2': nrm((L, GATE_LORA, RWKV_WIDTH), GATE_LORA ** -0.5),
        'rwkv_k_k': 0.85 + nrm((L, RWKV_WIDTH), 0.05),
        'rwkv_k_a': 1.0 + nrm((L, RWKV_WIDTH), 0.05),
        'rwkv_r_k': nrm((L, RWKV_HEADS, RWKV_HEAD_DIM), 0.1),
        'rwkv_gn_g': 1.0 + nrm((L, RWKV_WIDTH), 0.05),
        'rwkv_gn_b': nrm((L, RWKV_WIDTH), 0.02),
        'sgu_ln_g': 1.0 + nrm((L, SGU_WIDTH), 0.05),
        'sgu_ln_b': nrm((L, SGU_WIDTH), 0.02),
        'sgu_w': nrm((L, SGU_GROUPS, SGU_CHUNK, SGU_CHUNK), SGU_CHUNK ** -0.5),
        'sgu_b': 1.0 + nrm((L, SGU_GROUPS, SGU_CHUNK), 0.1),
        'w_branch': nrm((L, N_BRANCH, W, D), BETA * W ** -0.5),
        'w_out': nrm((L, D, D), BETA * D ** -0.5),
        'ln1_g': 1.0 + nrm((L, D), 0.05),
        'ln1_b': nrm((L, D), 0.02),
        'ln2_g': 1.0 + nrm((L, D), 0.05),
        'ln2_b': nrm((L, D), 0.02),
        'ffn_w_gu': nrm((L, D, 2 * D_FF), D ** -0.5),
        'ffn_w_down': nrm((L, D_FF, D), BETA * D_FF ** -0.5),
    }


def reference(x, c, ctx, c_ctx, w_ada, b_ada, w_in, na_rpb, rwkv_mu_prev, rwkv_mu_next, rwkv_w0, rwkv_w2,
              rwkv_a0, rwkv_a2, rwkv_g2, rwkv_k_k, rwkv_k_a, rwkv_r_k, rwkv_gn_g, rwkv_gn_b, sgu_ln_g, sgu_ln_b,
              sgu_w, sgu_b, w_branch, w_out, ln1_g, ln1_b, ln2_g, ln2_b, ffn_w_gu, ffn_w_down):
    silu_c = jax.nn.silu(c)
    silu_cc = jax.nn.silu(c_ctx)
    xc = ctx
    for l in range(DEPTH):
        last = l == DEPTH - 1
        sh_m, sc_m, g_m, sh_f, sc_f, g_f = jnp.split((silu_c @ w_ada[l] + b_ada[l])[:, None, :], 6, axis=-1)
        csh_m, csc_m, cg_m, csh_f, csc_f, cg_f = jnp.split(silu_cc @ w_ada[l] + b_ada[l], 6, axis=-1)
        y, y_c = token_mixer(x * (1.0 + sc_m) + sh_m, xc * (1.0 + csc_m) + csh_m, w_in[l], na_rpb[l],
                             rwkv_mu_prev[l], rwkv_mu_next[l], rwkv_w0[l], rwkv_w2[l], rwkv_a0[l], rwkv_a2[l],
                             rwkv_g2[l], rwkv_k_k[l], rwkv_k_a[l], rwkv_r_k[l], rwkv_gn_g[l], rwkv_gn_b[l],
                             sgu_ln_g[l], sgu_ln_b[l], sgu_w[l], sgu_b[l], w_branch[l], w_out[l], not last)
        x = layer_norm(ALPHA * x + g_m * y, ln1_g[l], ln1_b[l])
        x = layer_norm(ALPHA * x + g_f * swiglu(x * (1.0 + sc_f) + sh_f, ffn_w_gu[l], ffn_w_down[l]),
                       ln2_g[l], ln2_b[l])
        if not last:
            xc = layer_norm(ALPHA * xc + cg_m * y_c, ln1_g[l], ln1_b[l])
            xc = layer_norm(ALPHA * xc + cg_f * swiglu(xc * (1.0 + csc_f) + csh_f, ffn_w_gu[l], ffn_w_down[l]),
                            ln2_g[l], ln2_b[l])
    return x
```

```cpp
#include <hip/hip_runtime.h>
#include <hip/hip_cooperative_groups.h>
#include <cstdio>
namespace cg = cooperative_groups;

#define LAS __attribute__((address_space(3)))
typedef unsigned short bf16_t;
typedef short bf16x8 __attribute__((ext_vector_type(8)));
typedef short bf16x4 __attribute__((ext_vector_type(4)));
typedef float f32x4 __attribute__((ext_vector_type(4)));
typedef unsigned u32x4 __attribute__((ext_vector_type(4)));
typedef unsigned u32x2 __attribute__((ext_vector_type(2)));

#ifndef EN_NA
#define EN_NA 1
#endif
#ifndef EN_RWKV
#define EN_RWKV 1
#endif
#ifndef EN_SGU
#define EN_SGU 1
#endif
#ifndef EN_MIX
#define EN_MIX 1
#endif
#ifndef EN_FFN
#define EN_FFN 1
#endif

constexpr int DM = 1024, NB = 4, SEQ = 4096, NL = 4, CTXL = 256;
constexpr int NLAT = NB * SEQ, NCTX = NB * CTXL, NTOK = NLAT + NCTX;
constexpr int DIN = 7552, DINP = 7680, LDP = 7552;
constexpr int OFF_Q = 3072, OFF_K = 3584, OFF_V = 4096, OFF_RW = 4608, OFF_SG = 6528;
constexpr int DFF = 2816;
constexpr float ALPHA = 1.681792830507429f;
constexpr int NTHR = 512;
constexpr int SMEM_BYTES = 131072 + 16;

constexpr size_t SZ_TOK512 = (size_t)NTOK * 512 * 2;
constexpr size_t O_XC = 0;
constexpr size_t O_MOD = O_XC + (size_t)NCTX * DM * 4;
constexpr size_t O_H = O_MOD + (size_t)NL * 5 * 6144 * 4;
constexpr size_t O_P = O_H + (size_t)NTOK * DM * 2;
constexpr size_t O_WIN = O_P + (size_t)NTOK * LDP * 2;
constexpr size_t O_WB = O_WIN + (size_t)DINP * DM * 2;
constexpr size_t O_WOUT = O_WB + (size_t)3 * DM * 512 * 2;
constexpr size_t O_WGU = O_WOUT + (size_t)DM * DM * 2;
constexpr size_t O_WDN = O_WGU + (size_t)2 * DFF * DM * 2;
constexpr size_t O_W2T = O_WDN + (size_t)2 * DM * DFF * 2;
constexpr size_t O_A2T = O_W2T + (size_t)NL * 2 * 512 * 64 * 2;
constexpr size_t O_G2T = O_A2T + (size_t)NL * 2 * 512 * 64 * 2;
constexpr size_t O_SGW = O_G2T + (size_t)NL * 512 * 128 * 2;
constexpr size_t O_VT = O_SGW + (size_t)NL * 8 * 128 * 128 * 2;
constexpr size_t O_VS = O_VT + SZ_TOK512;
constexpr size_t O_KK = O_VS + SZ_TOK512;
constexpr size_t O_OMD = O_KK + SZ_TOK512;
constexpr size_t O_AA = O_OMD + 2 * SZ_TOK512;
constexpr size_t O_GG = O_AA + 2 * SZ_TOK512;
constexpr size_t O_BAR = O_GG + SZ_TOK512;
constexpr size_t WS_TOTAL = O_BAR + 16384;
static_assert(WS_TOTAL <= 494927872ull, "workspace too large");

struct Params {
    const float* in[32];
    float* out;
    unsigned char* ws;
    int rep[16];
};

__device__ __forceinline__ int otid() { int t = threadIdx.x; asm volatile("" : "+v"(t)); return t; }
__device__ __forceinline__ float bf2f(bf16_t b) { return __uint_as_float(((unsigned)b) << 16); }
typedef __bf16 bf16v2_t __attribute__((ext_vector_type(2)));
typedef float f32v2_t __attribute__((ext_vector_type(2)));
__device__ __forceinline__ unsigned cvt_pk_bf16(float lo, float hi) { const f32v2_t f = {lo, hi}; const bf16v2_t b = __builtin_convertvector(f, bf16v2_t); return __builtin_bit_cast(unsigned, b); }
__device__ __forceinline__ bf16_t f2bf(float f) { return (bf16_t)(cvt_pk_bf16(f, 0.f) & 0xffffu); }
__device__ __forceinline__ void unpack8(const u32x4 v, float (&f)[8]) {
#pragma unroll
    for (int i = 0; i < 4; ++i) { f[2 * i] = __uint_as_float(v[i] << 16); f[2 * i + 1] = __uint_as_float(v[i] & 0xffff0000u); }
}
__device__ __forceinline__ u32x4 pack8(const float (&f)[8]) {
    u32x4 r;
#pragma unroll
    for (int i = 0; i < 4; ++i) r[i] = cvt_pk_bf16(f[2 * i], f[2 * i + 1]);
    return r;
}
__device__ __forceinline__ void unpack4(const u32x2 v, float (&f)[4]) {
    f[0] = __uint_as_float(v[0] << 16); f[1] = __uint_as_float(v[0] & 0xffff0000u);
    f[2] = __uint_as_float(v[1] << 16); f[3] = __uint_as_float(v[1] & 0xffff0000u);
}
__device__ __forceinline__ float sigmoidf_(float x) { return 1.f / (1.f + __expf(-x)); }
__device__ __forceinline__ float gelu_tanh(float x) { const float y = 0.7978845608028654f * (x + 0.044715f * x * x * x); return x / (1.f + __expf(-2.f * y)); }
__device__ __forceinline__ float* xrow(const Params& p, int row) { return row < NLAT ? p.out + (size_t)row * DM : (float*)(p.ws + O_XC) + (size_t)(row - NLAT) * DM; }
__device__ __forceinline__ int mod_batch(int row) { return row < NLAT ? (row >> 12) : 4; }

constexpr int BM = 256, BK = 64, HALF = 128, HTB = HALF * BK * 2, NXCD = 8, WGM = 8;
__device__ __forceinline__ int lds_byte(int r, int c) { const int st = (r >> 4) * 2 + (c >> 5), rr = r & 15, cc = c & 31, ob = rr * 64 + cc * 2; return st * 1024 + (ob ^ (((ob >> 9) & 1) << 5)); }
__device__ __forceinline__ void stage_rc(int b, int& R, int& C) { const int st = b / 1024, sb = b % 1024, swz = sb ^ (((sb >> 9) & 1) << 5); R = (st >> 1) * 16 + swz / 64; C = (st & 1) * 32 + (swz % 64) / 2; }
__device__ __forceinline__ int perm32(int rho) { const int n = rho >> 4, i = rho & 15; return 8 * (i >> 2) + 4 * n + (i & 3); }

struct Unit { int pm, pn, z; };
struct GemmDesc { const bf16_t* A0; const bf16_t* A1; const bf16_t* A2; const bf16_t* B0; const bf16_t* B1; const bf16_t* B2; int lda, K; };

struct TileOrder {
    int nM, nN, nwg, G, c, nz;
    __device__ void init(int nM_, int nN_, int G_, int c_, int nz_) { nM = nM_; nN = nN_; nwg = nM * nN; G = G_; c = c_; nz = nz_; }
    __device__ bool next(int i, Unit& u) const {
        const int it = i / nz; u.z = i - it * nz;
        const long L = (long)it * G + c; if (L >= nwg) return false;
        int wgid = (int)L; { const int q = nwg / NXCD, r = nwg % NXCD, xcd = wgid % NXCD, off = wgid / NXCD; wgid = (xcd < r ? xcd * (q + 1) : r * (q + 1) + (xcd - r) * q) + off; }
        const int nig = WGM * nN, gid = wgid / nig, fm = gid * WGM, gsz = (nM - fm) < WGM ? (nM - fm) : WGM;
        u.pm = fm + ((wgid % nig) % gsz); u.pn = (wgid % nig) / gsz; return true;
    }
};

typedef f32x4 Acc[2][2][4][2];
__device__ __forceinline__ void zero_acc(Acc& acc) {
#pragma unroll
    for (int a = 0; a < 2; ++a)
#pragma unroll
        for (int b = 0; b < 2; ++b)
#pragma unroll
            for (int m = 0; m < 4; ++m)
#pragma unroll
                for (int n = 0; n < 2; ++n) acc[a][b][m][n] = (f32x4){0.f, 0.f, 0.f, 0.f};
}

struct EpiP {
    static constexpr bool PERM = true;
    bf16_t* P; bf16_t* VT;
    __device__ __forceinline__ void operator()(Acc& acc, const Unit& u, int wr, int wc, int fr, int fq) const {
        const int row0 = u.pm * BM + wr * 64 + fr, colb = u.pn * BM + wc * 32 + 8 * fq;
        const bool isv = (u.pn == 16 || u.pn == 17);
#pragma unroll
        for (int ai = 0; ai < 2; ++ai)
#pragma unroll
            for (int m = 0; m < 4; ++m) {
                const int row = row0 + ai * HALF + m * 16;
#pragma unroll
                for (int bj = 0; bj < 2; ++bj) {
                    const int col = colb + bj * HALF;
                    const f32x4 v0 = acc[ai][bj][m][0], v1 = acc[ai][bj][m][1];
                    u32x4 o; o[0] = cvt_pk_bf16(v0[0], v0[1]); o[1] = cvt_pk_bf16(v0[2], v0[3]); o[2] = cvt_pk_bf16(v1[0], v1[1]); o[3] = cvt_pk_bf16(v1[2], v1[3]);
                    if (col < DIN) *(u32x4*)(P + (size_t)row * LDP + col) = o;
                    if (isv) {
                        bf16_t* vt = VT + (size_t)(col - OFF_V) * NTOK + row;
#pragma unroll
                        for (int e = 0; e < 4; ++e) { vt[(size_t)(2 * e) * NTOK] = (bf16_t)(o[e] & 0xffffu); vt[(size_t)(2 * e + 1) * NTOK] = (bf16_t)(o[e] >> 16); }
                    }
                }
            }
        zero_acc(acc);
    }
};

struct EpiMerge {
    static constexpr bool PERM = true;
    const bf16_t* P; bf16_t* Y;
    __device__ __forceinline__ void operator()(Acc& acc, const Unit& u, int wr, int wc, int fr, int fq) const {
        const int row0 = u.pm * BM + wr * 64 + fr, colb = u.pn * BM + wc * 32 + 8 * fq;
        const int zb = u.z < 2 ? 1024 : 0;
#pragma unroll
        for (int ai = 0; ai < 2; ++ai) {
            u32x4 ga[4][2], gb[4][2];
#pragma unroll
            for (int m = 0; m < 4; ++m)
#pragma unroll
                for (int bj = 0; bj < 2; ++bj) {
                    const bf16_t* gp = P + (size_t)(row0 + ai * HALF + m * 16) * LDP + u.z * 1024 + colb + bj * HALF;
                    ga[m][bj] = *(const u32x4*)gp; gb[m][bj] = *(const u32x4*)(gp + zb);
                }
#pragma unroll
            for (int m = 0; m < 4; ++m)
#pragma unroll
                for (int bj = 0; bj < 2; ++bj) {
                    float fa[8], fb[8], sc[8];
                    unpack8(ga[m][bj], fa); unpack8(gb[m][bj], fb);
#pragma unroll
                    for (int e = 0; e < 8; ++e) { const float ra = __builtin_amdgcn_rcpf(1.f + __expf(-fa[e])); sc[e] = u.z < 2 ? (1.f + __expf(-fb[e])) * ra : ra; }
                    f32x4 v0 = acc[ai][bj][m][0], v1 = acc[ai][bj][m][1];
#pragma unroll
                    for (int e = 0; e < 4; ++e) { v0[e] *= sc[e]; v1[e] *= sc[4 + e]; }
                    if (u.z == 2) {
                        u32x4 o; o[0] = cvt_pk_bf16(v0[0], v0[1]); o[1] = cvt_pk_bf16(v0[2], v0[3]); o[2] = cvt_pk_bf16(v1[0], v1[1]); o[3] = cvt_pk_bf16(v1[2], v1[3]);
                        *(u32x4*)(Y + (size_t)(row0 + ai * HALF + m * 16) * DM + colb + bj * HALF) = o;
                        acc[ai][bj][m][0] = (f32x4){0.f, 0.f, 0.f, 0.f}; acc[ai][bj][m][1] = (f32x4){0.f, 0.f, 0.f, 0.f};
                    } else { acc[ai][bj][m][0] = v0; acc[ai][bj][m][1] = v1; }
                }
        }
    }
};

struct EpiRes {
    static constexpr bool PERM = false;
    Params p; const float* mod;
    int gidx; bool store;
    __device__ __forceinline__ void operator()(Acc& acc, const Unit& u, int wr, int wc, int fr, int fq) const {
        const int row0 = u.pm * BM + wr * 64 + fr, colb = u.pn * BM + wc * 32 + 4 * fq;
        const float* gm = mod + mod_batch(u.pm * BM) * 6144 + gidx * 1024;
        f32x4 gv[2][2];
#pragma unroll
        for (int bj = 0; bj < 2; ++bj)
#pragma unroll
            for (int n = 0; n < 2; ++n) gv[bj][n] = *(const f32x4*)(gm + colb + bj * HALF + n * 16);
#pragma unroll
        for (int ai = 0; ai < 2; ++ai) {
            f32x4 xv[4][2][2];
#pragma unroll
            for (int m = 0; m < 4; ++m) {
                const float* rp = xrow(p, row0 + ai * HALF + m * 16) + colb;
#pragma unroll
                for (int bj = 0; bj < 2; ++bj)
#pragma unroll
                    for (int n = 0; n < 2; ++n) xv[m][bj][n] = *(const f32x4*)(rp + bj * HALF + n * 16);
            }
#pragma unroll
            for (int m = 0; m < 4; ++m) {
                float* rp = xrow(p, row0 + ai * HALF + m * 16) + colb;
#pragma unroll
                for (int bj = 0; bj < 2; ++bj)
#pragma unroll
                    for (int n = 0; n < 2; ++n) if (store) *(f32x4*)(rp + bj * HALF + n * 16) = xv[m][bj][n] * ALPHA + gv[bj][n] * acc[ai][bj][m][n];
            }
        }
        zero_acc(acc);
    }
};

struct EpiGlu {
    static constexpr bool PERM = true;
    bf16_t* HID;
    __device__ __forceinline__ void operator()(Acc& acc, const Unit& u, int wr, int wc, int fr, int fq) const {
        const int row0 = u.pm * BM + wr * 64 + fr, col = u.pn * HALF + wc * 32 + 8 * fq;
#pragma unroll
        for (int ai = 0; ai < 2; ++ai)
#pragma unroll
            for (int m = 0; m < 4; ++m) {
                const int row = row0 + ai * HALF + m * 16;
                float o[8];
#pragma unroll
                for (int n = 0; n < 2; ++n)
#pragma unroll
                    for (int e = 0; e < 4; ++e) { const float g = acc[ai][0][m][n][e], up = acc[ai][1][m][n][e]; o[n * 4 + e] = g * __builtin_amdgcn_rcpf(1.f + __expf(-g)) * up; }
                *(u32x4*)(HID + (size_t)row * DFF + col) = pack8(o);
            }
        zero_acc(acc);
    }
};

template <class Epi>
__device__ __forceinline__ void gemm_phase(LAS unsigned char* lds, const GemmDesc g, const TileOrder& S, const Epi& E) {
    const int tid = otid(), wid = __builtin_amdgcn_readfirstlane(tid >> 6), lane = tid & 63, wr = wid >> 2, wc = wid & 3, fr = lane & 15, fq = lane >> 4;
    const int K = g.K, nt = K / BK, lda = g.lda;
    unsigned voffA[2], voffB[2];
#pragma unroll
    for (int i = 0; i < 2; ++i) { int R, C; stage_rc(tid * 16 + i * 8192, R, C); const int Rb = Epi::PERM ? ((R & ~31) + perm32(R & 31)) : R;
        voffA[i] = (unsigned)(R * lda + C) * 2u; voffB[i] = (unsigned)(Rb * K + C) * 2u; }
    const size_t kstep = (size_t)(BK * 2);
    const size_t hstepA = (size_t)HALF * lda * 2, hstepB = (size_t)HALF * K * 2;
    const size_t tstepA = 2 * hstepA, tstepB = 2 * hstepB;
    const unsigned ldsw = (unsigned)wid * 1024u;
    const int aoff = lds_byte(wr * 64 + fr, fq * 8), boff = lds_byte(wc * 32 + fr, fq * 8);
#define PG8_SA(b, h) (((b) * 2 + (h)) * HTB)
#define PG8_SB(b, h) ((4 + (b) * 2 + (h)) * HTB)
#define PG8_STAGE(bufoff, gbase, voff) do { _Pragma("unroll") for (int _i = 0; _i < 2; ++_i) \
        __builtin_amdgcn_global_load_lds((const unsigned*)((const char*)(gbase) + (voff)[_i]), (LAS unsigned*)(lds + (bufoff) + ldsw + _i * 8192), 16, 0, 0); } while (0)
#define PG8_LDA(dst, b, h) do { _Pragma("unroll") for (int m = 0; m < 4; ++m) _Pragma("unroll") for (int k = 0; k < 2; ++k) dst[m][k] = *(const LAS bf16x8*)(lds + PG8_SA(b, h) + aoff + m * 2048 + k * 1024); } while (0)
#define PG8_LDB(dst, b, h) do { _Pragma("unroll") for (int n = 0; n < 2; ++n) _Pragma("unroll") for (int k = 0; k < 2; ++k) dst[n][k] = *(const LAS bf16x8*)(lds + PG8_SB(b, h) + boff + n * 2048 + k * 1024); } while (0)
#define PG8_MMA(ai, bj, At, Bt) do { __builtin_amdgcn_s_setprio(1); _Pragma("unroll") for (int m = 0; m < 4; ++m) _Pragma("unroll") for (int n = 0; n < 2; ++n) _Pragma("unroll") for (int k = 0; k < 2; ++k) \
        acc[ai][bj][m][n] = __builtin_amdgcn_mfma_f32_16x16x32_bf16(Bt[n][k], At[m][k], acc[ai][bj][m][n], 0, 0, 0); __builtin_amdgcn_s_setprio(0); } while (0)
#define PG8_WAIT_V(n) asm volatile("s_waitcnt vmcnt(" #n ")" ::: "memory")
#define PG8_WAIT_L(n) asm volatile("s_waitcnt lgkmcnt(" #n ")" ::: "memory")
#define PG8_BAR __builtin_amdgcn_s_barrier()
#define PG8_SCHED __builtin_amdgcn_sched_barrier(0)
    Unit cur, nxt; int ui = 0;
    if (!S.next(0, cur)) return;
    Acc acc;
    zero_acc(acc);
    bf16x8 At[4][2], B0[2][2], B1[2][2];
    const char* cA = (const char*)(cur.z == 0 ? g.A0 : cur.z == 1 ? g.A1 : g.A2) + (size_t)cur.pm * tstepA;
    const char* cB = (const char*)(cur.z == 0 ? g.B0 : cur.z == 1 ? g.B1 : g.B2) + (size_t)cur.pn * tstepB;
    PG8_STAGE(PG8_SB(0, 0), cB, voffB); PG8_STAGE(PG8_SB(0, 1), cB + hstepB, voffB); PG8_STAGE(PG8_SA(0, 0), cA, voffA); PG8_STAGE(PG8_SA(0, 1), cA + hstepA, voffA);
    if (wr == 1) PG8_BAR;
    PG8_WAIT_V(2); PG8_BAR;
    PG8_STAGE(PG8_SB(1, 0), cB + kstep, voffB); PG8_STAGE(PG8_SA(1, 0), cA + kstep, voffA); PG8_STAGE(PG8_SB(1, 1), cB + hstepB + kstep, voffB);
    PG8_WAIT_V(6); PG8_BAR;
    for (;;) {
        const bool has_next = S.next(ui + 1, nxt);
        const char* nA = has_next ? (const char*)(nxt.z == 0 ? g.A0 : nxt.z == 1 ? g.A1 : g.A2) + (size_t)nxt.pm * tstepA : cA;
        const char* nB = has_next ? (const char*)(nxt.z == 0 ? g.B0 : nxt.z == 1 ? g.B1 : g.B2) + (size_t)nxt.pn * tstepB : cB;
        for (int t = 0; t < nt; t += 2) {
            const bool last = (t == nt - 2);
            const char* a1 = cA + (size_t)(t + 1) * kstep;
            const char* a2 = last ? nA : cA + (size_t)(t + 2) * kstep; const char* b2 = last ? nB : cB + (size_t)(t + 2) * kstep;
            const char* a3 = a2 + kstep; const char* b3 = b2 + kstep;
            PG8_LDB(B0, 0, 0); PG8_LDB(B1, 0, 1); PG8_SCHED; PG8_LDA(At, 0, 0); PG8_STAGE(PG8_SA(1, 1), a1 + hstepA, voffA);
            PG8_WAIT_V(8); PG8_WAIT_L(0); PG8_BAR; PG8_MMA(0, 0, At, B0); PG8_MMA(0, 1, At, B1); PG8_BAR; PG8_SCHED;
            PG8_LDA(At, 0, 1); PG8_STAGE(PG8_SB(0, 0), b2, voffB); PG8_STAGE(PG8_SB(0, 1), b2 + hstepB, voffB); PG8_STAGE(PG8_SA(0, 0), a2, voffA);
            PG8_WAIT_V(8); PG8_WAIT_L(0); PG8_BAR; PG8_MMA(1, 0, At, B0); PG8_MMA(1, 1, At, B1); PG8_BAR; PG8_SCHED;
            PG8_LDB(B0, 1, 0); PG8_LDB(B1, 1, 1); PG8_SCHED; PG8_LDA(At, 1, 0); PG8_STAGE(PG8_SA(0, 1), a2 + hstepA, voffA);
            PG8_WAIT_V(8); PG8_WAIT_L(0); PG8_BAR; PG8_MMA(0, 0, At, B0); PG8_MMA(0, 1, At, B1); PG8_BAR; PG8_SCHED;
            PG8_LDA(At, 1, 1); PG8_STAGE(PG8_SB(1, 0), b3, voffB); PG8_STAGE(PG8_SB(1, 1), b3 + hstepB, voffB); PG8_STAGE(PG8_SA(1, 0), a3, voffA);
            PG8_WAIT_V(8); PG8_WAIT_L(0); PG8_BAR; PG8_MMA(1, 0, At, B0); PG8_MMA(1, 1, At, B1); PG8_BAR; PG8_SCHED;
        }
        if (wr == 0) PG8_BAR;
        E(acc, cur, wr, wc, fr, fq);
        if (!has_next) break;
        cur = nxt; cA = nA; cB = nB; ++ui;
        if (wr == 1) PG8_BAR;
    }
    PG8_WAIT_V(0);
    PG8_BAR;
#undef PG8_SA
#undef PG8_SB
#undef PG8_STAGE
#undef PG8_LDA
#undef PG8_LDB
#undef PG8_MMA
#undef PG8_WAIT_V
#undef PG8_WAIT_L
#undef PG8_BAR
#undef PG8_SCHED
}

__device__ void phase_mod(const Params& p, float* lds, int l0, int nl, int b0, int nb) {
    const int tid = otid();
    for (int i = tid; i < 5 * 1024; i += NTHR) { const float c = i < 4096 ? p.in[1][i] : p.in[3][i - 4096]; lds[i] = c / (1.f + __expf(-c)); }
    __syncthreads();
    float* red = lds + 5 * 1024;
    float* MOD = (float*)(p.ws + O_MOD);
    const int col = tid & 63, kp = tid >> 6;
    for (int item = (int)blockIdx.x - b0; item < nl * 96; item += nb) {
        const int l = l0 + item / 96, j0 = (item % 96) * 64;
        const float* w = p.in[4] + ((size_t)l * 1024 + kp * 128) * 6144 + j0 + col;
        float a0 = 0.f, a1 = 0.f, a2 = 0.f, a3 = 0.f, a4 = 0.f;
        const float* s = lds + kp * 128;
#pragma unroll 16
        for (int k = 0; k < 128; ++k) { const float wv = w[(size_t)k * 6144]; a0 += s[k] * wv; a1 += s[1024 + k] * wv; a2 += s[2048 + k] * wv; a3 += s[3072 + k] * wv; a4 += s[4096 + k] * wv; }
        red[(kp * 5 + 0) * 64 + col] = a0; red[(kp * 5 + 1) * 64 + col] = a1; red[(kp * 5 + 2) * 64 + col] = a2; red[(kp * 5 + 3) * 64 + col] = a3; red[(kp * 5 + 4) * 64 + col] = a4;
        __syncthreads();
        if (tid < 320) {
            const int s5 = tid >> 6, cc = tid & 63;
            float v = p.in[5][l * 6144 + j0 + cc];
#pragma unroll
            for (int q = 0; q < 8; ++q) v += red[(q * 5 + s5) * 64 + cc];
            MOD[((size_t)l * 5 + s5) * 6144 + j0 + cc] = v;
        }
        __syncthreads();
    }
}

struct ConvJob { const float* src; bf16_t* dst; int K, ldsrc, nvalid, mode; };
__device__ void conv_tile(const ConvJob& j, int kt, int ntile, float* lds) {
    const int tid = otid();
    const int k0 = kt * 64, n0 = ntile * 64;
    int scol = n0; bool valid = n0 < j.nvalid;
    if (j.mode == 1) { const int pn = n0 >> 8, bj = (n0 >> 7) & 1, j0 = n0 & 127; scol = bj * DFF + pn * 128 + j0; }
    {
        const int r = tid >> 3, c8 = (tid & 7) * 8;
        f32x4 v0 = {0.f, 0.f, 0.f, 0.f}, v1 = {0.f, 0.f, 0.f, 0.f};
        if (valid) { const float* sp = j.src + (size_t)(k0 + r) * j.ldsrc + scol + c8; v0 = *(const f32x4*)sp; v1 = *(const f32x4*)(sp + 4); }
        float* t = lds + r * 65 + c8;
        t[0] = v0[0]; t[1] = v0[1]; t[2] = v0[2]; t[3] = v0[3]; t[4] = v1[0]; t[5] = v1[1]; t[6] = v1[2]; t[7] = v1[3];
    }
    __syncthreads();
    {
        const int n = tid >> 3, k8 = (tid & 7) * 8;
        float f[8];
#pragma unroll
        for (int e = 0; e < 8; ++e) f[e] = lds[(k8 + e) * 65 + n];
        *(u32x4*)(j.dst + (size_t)(n0 + n) * j.K + k0 + k8) = pack8(f);
    }
    __syncthreads();
}
__device__ void conv_win(const Params& p, int l, int idx, float* lds) {
    ConvJob j; j.src = p.in[6] + (size_t)l * DM * DIN; j.dst = (bf16_t*)(p.ws + O_WIN); j.K = DM; j.ldsrc = DIN; j.nvalid = DIN; j.mode = 0;
    conv_tile(j, idx & 15, idx >> 4, lds);
}
__device__ void conv_small(const Params& p, int idx, float* lds) {
    const int tid = otid();
    if (idx < 128) {
        const int which = idx >> 6, r = idx & 63, ld = r >> 3, ntile = r & 7;
        ConvJob j; j.src = p.in[which ? 13 : 11] + (size_t)ld * 64 * 512; j.dst = (bf16_t*)(p.ws + (which ? O_A2T : O_W2T)) + (size_t)ld * 512 * 64; j.K = 64; j.ldsrc = 512; j.nvalid = 512; j.mode = 0;
        conv_tile(j, 0, ntile, lds);
    } else if (idx < 192) {
        const int r = idx - 128, l = r >> 4, kt = (r >> 3) & 1, ntile = r & 7;
        ConvJob j; j.src = p.in[14] + (size_t)l * 128 * 512; j.dst = (bf16_t*)(p.ws + O_G2T) + (size_t)l * 512 * 128; j.K = 128; j.ldsrc = 512; j.nvalid = 512; j.mode = 0;
        conv_tile(j, kt, ntile, lds);
    } else {
        const int r = idx - 192;
        const float* s = p.in[22] + (size_t)r * 4096 + tid * 8;
        float f[8]; const f32x4 v0 = *(const f32x4*)s, v1 = *(const f32x4*)(s + 4);
        f[0] = v0[0]; f[1] = v0[1]; f[2] = v0[2]; f[3] = v0[3]; f[4] = v1[0]; f[5] = v1[1]; f[6] = v1[2]; f[7] = v1[3];
        *(u32x4*)((bf16_t*)(p.ws + O_SGW) + (size_t)r * 4096 + tid * 8) = pack8(f);
    }
}
constexpr int NCONV_LAYER = 384 + 256 + 1408 + 704;
__device__ void conv_layer(const Params& p, int l, int idx, float* lds) {
    ConvJob j; j.mode = 0;
    if (idx < 384) { const int br = idx >> 7, r = idx & 127; j.src = p.in[24] + ((size_t)l * 3 + br) * 512 * DM; j.dst = (bf16_t*)(p.ws + O_WB) + (size_t)br * DM * 512; j.K = 512; j.ldsrc = DM; j.nvalid = DM; conv_tile(j, r & 7, r >> 3, lds); return; }
    idx -= 384;
    if (idx < 256) { j.src = p.in[25] + (size_t)l * DM * DM; j.dst = (bf16_t*)(p.ws + O_WOUT); j.K = DM; j.ldsrc = DM; j.nvalid = DM; conv_tile(j, idx & 15, idx >> 4, lds); return; }
    idx -= 256;
    if (idx < 1408) { j.src = p.in[30] + (size_t)l * DM * 2 * DFF; j.dst = (bf16_t*)(p.ws + O_WGU); j.K = DM; j.ldsrc = 2 * DFF; j.nvalid = 2 * DFF; j.mode = 1; conv_tile(j, idx & 15, idx >> 4, lds); return; }
    idx -= 1408;
    { j.src = p.in[31] + (size_t)l * DFF * DM; j.dst = (bf16_t*)(p.ws + O_WDN) + (size_t)(l & 1) * DM * DFF; j.K = DFF; j.ldsrc = DM; j.nvalid = DM; conv_tile(j, idx % 44, idx / 44, lds); }
}

__device__ void phase_rows(const Params& p, int mode, int l, int nrows, bool store) {
    const int tid_ = otid(); const int lane = tid_ & 63, gw = blockIdx.x * 8 + (tid_ >> 6), nw = gridDim.x * 8;
    const float* MOD = (const float*)(p.ws + O_MOD);
    bf16_t* H = (bf16_t*)(p.ws + O_H);
    const float* lg = mode == 1 ? p.in[26] + l * DM : p.in[28] + l * DM;
    const float* lb = mode == 1 ? p.in[27] + l * DM : p.in[29] + l * DM;
    const int ml = mode == 2 ? l + 1 : l;
    const bool wh = !(mode == 2 && l == NL - 1);
    const int sci = mode == 1 ? 4 : 1, shi = mode == 1 ? 3 : 0;
#define ROWS_SRC(r) (mode == 0 ? ((r) < NLAT ? p.in[0] + (size_t)(r) * DM : p.in[2] + (size_t)((r) - NLAT) * DM) : (const float*)xrow(p, (r)))
    f32x4 nv[4];
    if (gw < nrows) { const float* s0 = ROWS_SRC(gw);
#pragma unroll
        for (int i = 0; i < 4; ++i) nv[i] = *(const f32x4*)(s0 + i * 256 + lane * 4); }
    for (int row = gw; row < nrows; row += nw) {
        float* xp = xrow(p, row);
        f32x4 v[4];
#pragma unroll
        for (int i = 0; i < 4; ++i) v[i] = nv[i];
        if (row + nw < nrows) { const float* s1 = ROWS_SRC(row + nw);
#pragma unroll
            for (int i = 0; i < 4; ++i) nv[i] = *(const f32x4*)(s1 + i * 256 + lane * 4); }
        if (mode == 0) {
#pragma unroll
            for (int i = 0; i < 4; ++i) { if (store) *(f32x4*)(xp + i * 256 + lane * 4) = v[i]; }
        } else {
            float s = 0.f;
#pragma unroll
            for (int i = 0; i < 4; ++i) s += v[i][0] + v[i][1] + v[i][2] + v[i][3];
#pragma unroll
            for (int o = 1; o < 64; o <<= 1) s += __shfl_xor(s, o);
            const float mu = s * (1.f / 1024.f);
            float q = 0.f;
#pragma unroll
            for (int i = 0; i < 4; ++i) { v[i] -= mu; q += v[i][0] * v[i][0] + v[i][1] * v[i][1] + v[i][2] * v[i][2] + v[i][3] * v[i][3]; }
#pragma unroll
            for (int o = 1; o < 64; o <<= 1) q += __shfl_xor(q, o);
            const float rs = rsqrtf(q * (1.f / 1024.f) + 1e-5f);
#pragma unroll
            for (int i = 0; i < 4; ++i) { const f32x4 g4 = *(const f32x4*)(lg + i * 256 + lane * 4), b4 = *(const f32x4*)(lb + i * 256 + lane * 4); v[i] = v[i] * rs * g4 + b4; if (store) *(f32x4*)(xp + i * 256 + lane * 4) = v[i]; }
        }
        if (wh && store) {
            const float* mb = MOD + ((size_t)ml * 5 + mod_batch(row)) * 6144;
#pragma unroll
            for (int i = 0; i < 4; ++i) {
                const f32x4 sc = *(const f32x4*)(mb + sci * 1024 + i * 256 + lane * 4), sh = *(const f32x4*)(mb + shi * 1024 + i * 256 + lane * 4);
                const f32x4 h = v[i] * (sc + 1.f) + sh;
                u32x2 o; o[0] = cvt_pk_bf16(h[0], h[1]); o[1] = cvt_pk_bf16(h[2], h[3]);
                *(u32x2*)(H + (size_t)row * DM + i * 256 + lane * 4) = o;
            }
        }
    }
}

constexpr int ALD = 392;
__device__ void phase_prep(const Params& p, int l, unsigned char* smem) {
    const int tid = otid(), wid = tid >> 6, lane = tid & 63, fr = lane & 15, fq = lane >> 4;
    const bf16_t* P = (const bf16_t*)(p.ws + O_P);
    bf16_t* RS = (bf16_t*)(p.ws + O_H); bf16_t* KS = RS + (size_t)NTOK * 512;
    bf16_t* VS = (bf16_t*)(p.ws + O_VS); bf16_t* KK = (bf16_t*)(p.ws + O_KK);
    bf16_t* OMD = (bf16_t*)(p.ws + O_OMD); bf16_t* AA = (bf16_t*)(p.ws + O_AA); bf16_t* GG = (bf16_t*)(p.ws + O_GG);
    const bf16_t* W2T = (const bf16_t*)(p.ws + O_W2T) + (size_t)l * 2 * 512 * 64;
    const bf16_t* A2T = (const bf16_t*)(p.ws + O_A2T) + (size_t)l * 2 * 512 * 64;
    const bf16_t* G2T = (const bf16_t*)(p.ws + O_G2T) + (size_t)l * 512 * 128;
    const float* mup = p.in[8] + l * 1920; const float* mun = p.in[9] + l * 1920;
    const float* kkw = p.in[15] + l * 512;
    const float* w0 = p.in[10] + l * 1024; const float* a0 = p.in[12] + l * 1024;
    bf16_t* At = (bf16_t*)smem;
    constexpr int PT = 68;
    for (int tile = blockIdx.x; tile < NTOK / PT; tile += gridDim.x) {
        {
            const int t0 = wid * 9, rbase = tile * PT + t0;
#pragma unroll 1
            for (int ch = 0; ch < 4; ++ch) {
                if (ch == 3 && lane >= 48) break;
                const int c = ch * 512 + lane * 8;
                u32x4 rw[11];
#pragma unroll
                for (int i = 0; i < 11; ++i) {
                    const int rr = min(max(rbase - 1 + i, 0), NTOK - 1);
                    rw[i] = *(const u32x4*)(P + (size_t)rr * LDP + OFF_RW + c);
                }
                const f32x4 mp0 = *(const f32x4*)(mup + c), mp1 = *(const f32x4*)(mup + c + 4), mn0 = *(const f32x4*)(mun + c), mn1 = *(const f32x4*)(mun + c + 4);
                f32x4 k0 = {0.f, 0.f, 0.f, 0.f}, k1 = {0.f, 0.f, 0.f, 0.f};
                if (ch == 1) { k0 = *(const f32x4*)(kkw + lane * 8); k1 = *(const f32x4*)(kkw + lane * 8 + 4); }
#pragma unroll
                for (int i = 0; i < 9; ++i) {
                    const int t = t0 + i, row = rbase + i;
                    if (t >= PT) break;
                    const bool first = row < NLAT ? ((row & 4095) == 0) : (((row - NLAT) & 255) == 0);
                    const bool lastt = row < NLAT ? ((row & 4095) == 4095) : (((row - NLAT) & 255) == 255);
                    float cur[8], prv[8], nxt[8], sv[8];
                    unpack8(rw[i + 1], cur); unpack8(rw[i], prv); unpack8(rw[i + 2], nxt);
#pragma unroll
                    for (int e = 0; e < 8; ++e) {
                        const float mp = e < 4 ? mp0[e] : mp1[e - 4], mn = e < 4 ? mn0[e] : mn1[e - 4];
                        const float pv = first ? 0.f : prv[e], nv = lastt ? 0.f : nxt[e];
                        sv[e] = cur[e] + mp * (pv - cur[e]) + mn * (nv - cur[e]);
                    }
                    if (ch == 0) *(u32x4*)(RS + (size_t)row * 512 + lane * 8) = pack8(sv);
                    else if (ch == 1) {
                        *(u32x4*)(KS + (size_t)row * 512 + lane * 8) = pack8(sv);
                        float kv[8], ss = 0.f;
#pragma unroll
                        for (int e = 0; e < 8; ++e) { kv[e] = sv[e] * (e < 4 ? k0[e] : k1[e - 4]); ss += kv[e] * kv[e]; }
                        ss += __shfl_xor(ss, 1); ss += __shfl_xor(ss, 2); ss += __shfl_xor(ss, 4);
                        const float rn = rsqrtf(ss + 1e-12f);
#pragma unroll
                        for (int e = 0; e < 8; ++e) kv[e] *= rn;
                        *(u32x4*)(KK + (size_t)row * 512 + lane * 8) = pack8(kv);
                    } else if (ch == 2) *(u32x4*)(VS + (size_t)row * 512 + lane * 8) = pack8(sv);
                    else {
                        const int cc = lane * 8;
                        if (cc < 128) {
#pragma unroll
                            for (int e = 0; e < 8; ++e) sv[e] = 1.f - 2.f / (__expf(2.f * sv[e]) + 1.f);
                        } else if (cc >= 256) {
#pragma unroll
                            for (int e = 0; e < 8; ++e) sv[e] = sigmoidf_(sv[e]);
                        }
                        *(u32x4*)(At + t * ALD + cc) = pack8(sv);
                    }
                }
            }
        }
        __syncthreads();
#pragma unroll 1
        for (int mat = 0; mat < 5; ++mat) {
            const int dir = mat & 1;
            const bf16_t* Wt = mat < 2 ? W2T + (size_t)dir * 512 * 64 : mat < 4 ? A2T + (size_t)dir * 512 * 64 : G2T;
            const int Kd = mat < 4 ? 64 : 128;
            const int koff = mat < 2 ? dir * 64 : mat < 4 ? 128 + dir * 64 : 256;
#pragma unroll 1
            for (int nt_ = 0; nt_ < 4; ++nt_) {
                const int cb = wid * 64 + nt_ * 16;
                bf16x8 wf[4];
                const bf16_t* wp = Wt + (size_t)(cb + fr) * Kd + fq * 8;
                wf[0] = *(const bf16x8*)wp; wf[1] = *(const bf16x8*)(wp + 32);
                if (mat == 4) { wf[2] = *(const bf16x8*)(wp + 64); wf[3] = *(const bf16x8*)(wp + 96); } else { wf[2] = wf[0]; wf[3] = wf[1]; }
                const int c4 = cb + fq * 4;
                f32x4 bias = {0.f, 0.f, 0.f, 0.f};
                if (mat < 2) bias = *(const f32x4*)(w0 + dir * 512 + c4); else if (mat < 4) bias = *(const f32x4*)(a0 + dir * 512 + c4);
#pragma unroll
                for (int tt = 0; tt < 5; ++tt) {
                    const bf16_t* ap = At + (tt * 16 + fr) * ALD + koff + fq * 8;
                    f32x4 acc = {0.f, 0.f, 0.f, 0.f};
                    acc = __builtin_amdgcn_mfma_f32_16x16x32_bf16(wf[0], *(const bf16x8*)ap, acc, 0, 0, 0);
                    acc = __builtin_amdgcn_mfma_f32_16x16x32_bf16(wf[1], *(const bf16x8*)(ap + 32), acc, 0, 0, 0);
                    if (mat == 4) {
                        acc = __builtin_amdgcn_mfma_f32_16x16x32_bf16(wf[2], *(const bf16x8*)(ap + 64), acc, 0, 0, 0);
                        acc = __builtin_amdgcn_mfma_f32_16x16x32_bf16(wf[3], *(const bf16x8*)(ap + 96), acc, 0, 0, 0);
                    }
                    const int row = tile * PT + tt * 16 + fr;
                    float o[4];
                    if (mat < 2) {
#pragma unroll
                        for (int e = 0; e < 4; ++e) {
                            const float x = -(bias[e] + acc[e]);
                            const float sp = fmaxf(x, 0.f) + __logf(1.f + __expf(-fabsf(x)));
                            const float ee = __expf(-sp - 0.5f);
                            o[e] = 1.f - __expf(-ee);
                        }
                    } else if (mat < 4) {
#pragma unroll
                        for (int e = 0; e < 4; ++e) o[e] = sigmoidf_(bias[e] + acc[e]);
                    } else {
#pragma unroll
                        for (int e = 0; e < 4; ++e) o[e] = acc[e];
                    }
                    u32x2 ov; ov[0] = cvt_pk_bf16(o[0], o[1]); ov[1] = cvt_pk_bf16(o[2], o[3]);
                    bf16_t* dst = mat < 2 ? OMD + (size_t)dir * NTOK * 512 : mat < 4 ? AA + (size_t)dir * NTOK * 512 : GG;
                    if (tt * 16 + fr < PT) *(u32x2*)(dst + (size_t)row * 512 + c4) = ov;
                }
            }
        }
        __syncthreads();
    }
}

constexpr int SC_KT = 0, SC_RT = 2304, SC_KBT = 4608, SC_BBT = 6656, SC_VT = 8704, SC_TM = 10752, SC_BM = 11264, SC_E = 11776, SC_F = 12288, SC_WC = 12800, SC_SLOT = 13056;
constexpr int SC_SCR = 8 * SC_SLOT, SC_SCRSZ = 6144;
static_assert(SC_SCR + 4 * SC_SCRSZ <= 131072, "scan LDS");
union BF8 { u32x4 u; bf16x8 v; };
__device__ __forceinline__ bf16x8 pack4z(const f32x4 d) { BF8 r; r.u[0] = cvt_pk_bf16(d[0], d[1]); r.u[1] = cvt_pk_bf16(d[2], d[3]); r.u[2] = 0u; r.u[3] = 0u; return r.v; }
__device__ __forceinline__ bf16x8 ldx4z(const bf16_t* q) { const bf16x4 t = *(const bf16x4*)q; const bf16x4 z = {0, 0, 0, 0}; return __builtin_shufflevector(t, z, 0, 1, 2, 3, 4, 5, 6, 7); }
__device__ __forceinline__ void stD16(bf16_t* M, const f32x4 d, int fr, int fq) {
#pragma unroll
    for (int jj = 0; jj < 4; ++jj) M[(fq * 4 + jj) * 16 + fr] = f2bf(d[jj]);
    asm volatile("" ::: "memory");
}
struct ConsOps { bf16x4 kt[4], rt[4], kb[4], bb[4], bm, e, tm, f, vy, vy2; f32x4 wc[4]; };
__device__ __forceinline__ bf16x8 z8(const bf16x4 t) { const bf16x4 z = {0, 0, 0, 0}; return __builtin_shufflevector(t, z, 0, 1, 2, 3, 4, 5, 6, 7); }
#define MFMA16(X, Y, C) __builtin_amdgcn_mfma_f32_16x16x32_bf16((X), (Y), (C), 0, 0, 0)

__device__ void scan_chain(const Params& p, int l, int chain, unsigned char* smem) {
    const int tid = otid(), wid = __builtin_amdgcn_readfirstlane(tid >> 6), lane = tid & 63, fr = lane & 15, fq = lane >> 4;
    const int dir = chain >> 5, b = (chain >> 3) & 3, h = chain & 7;
    const bf16_t* RS = (const bf16_t*)(p.ws + O_H); const bf16_t* KS = RS + (size_t)NTOK * 512;
    const bf16_t* VS = (const bf16_t*)(p.ws + O_VS); const bf16_t* KK = (const bf16_t*)(p.ws + O_KK);
    const bf16_t* OMD = (const bf16_t*)(p.ws + O_OMD) + (size_t)dir * NTOK * 512; const bf16_t* AA = (const bf16_t*)(p.ws + O_AA) + (size_t)dir * NTOK * 512;
    bf16_t* P = (bf16_t*)(p.ws + O_P);
    const int rstep = dir ? -1 : 1;
    constexpr int NGRP = (CTXL + SEQ) / 64;
    f32x4 st[2][4];
#pragma unroll
    for (int vt = 0; vt < 2; ++vt)
#pragma unroll
        for (int kt = 0; kt < 4; ++kt) st[vt][kt] = (f32x4){0.f, 0.f, 0.f, 0.f};
    const int li = lane >> 2, c16 = (lane & 3) * 16;
    float ka16[16];
#pragma unroll
    for (int e = 0; e < 16; ++e) ka16[e] = p.in[16][l * 512 + h * 64 + c16 + e];
    u32x4 raw[12];
#define SCAN_ROW0(cc) (((cc) * 16) < 256 ? NLAT + b * 256 + (dir ? 255 - (cc) * 16 : (cc) * 16) : b * 4096 + (dir ? 4095 - ((cc) * 16 - 256) : ((cc) * 16 - 256)))
#define SCAN_LOADRAW(cc) do { const size_t o_ = (size_t)(SCAN_ROW0(cc) + li * rstep) * 512 + h * 64 + c16; \
        raw[0] = *(const u32x4*)(RS + o_); raw[1] = *(const u32x4*)(RS + o_ + 8); raw[2] = *(const u32x4*)(KS + o_); raw[3] = *(const u32x4*)(KS + o_ + 8); \
        raw[4] = *(const u32x4*)(VS + o_); raw[5] = *(const u32x4*)(VS + o_ + 8); raw[6] = *(const u32x4*)(KK + o_); raw[7] = *(const u32x4*)(KK + o_ + 8); \
        raw[8] = *(const u32x4*)(OMD + o_); raw[9] = *(const u32x4*)(OMD + o_ + 8); raw[10] = *(const u32x4*)(AA + o_); raw[11] = *(const u32x4*)(AA + o_ + 8); } while (0)
#pragma unroll
    for (int e = 0; e < 12; ++e) raw[e] = (u32x4){0u, 0u, 0u, 0u};
    const bool is_prod = (wid & 2) == 0;
    const int pj = (wid & 1) + ((wid >> 2) << 1);
    const int cw = wid & 1;
    if (is_prod) SCAN_LOADRAW(pj);
    if (is_prod) {
#pragma unroll 1
      for (int g = -1; g < NGRP; ++g) {
        {
            const int j = pj, gg = g + 1;
            if (gg < NGRP) for (int rp2 = 0; rp2 < p.rep[14]; ++rp2) {
                const int s0 = (gg * 4 + j) * 16;
                const int row0 = s0 < 256 ? NLAT + b * 256 + (dir ? 255 - s0 : s0) : b * 4096 + (dir ? 4095 - (s0 - 256) : (s0 - 256));
                unsigned char* slot = smem + ((gg & 1) * 4 + j) * SC_SLOT;
                unsigned char* scr = smem + SC_SCR + j * SC_SCRSZ;
                bf16_t* Kt = (bf16_t*)(slot + SC_KT); bf16_t* Rt = (bf16_t*)(slot + SC_RT);
                bf16_t* Kh = (bf16_t*)(scr); bf16_t* Bh = (bf16_t*)(scr + 2304);
                bf16_t* P1 = (bf16_t*)(scr + 4608); bf16_t* P2 = (bf16_t*)(scr + 5120); bf16_t* P4 = (bf16_t*)(scr + 5632);
                float* Wbuf = (float*)(slot + SC_KBT);
                const u32x4 vraw0 = raw[4], vraw1 = raw[5];
                const u32x4 cr0 = raw[0], cr1 = raw[1], ck0 = raw[2], ck1 = raw[3], cq0 = raw[6], cq1 = raw[7], ca0 = raw[10], ca1 = raw[11];
                f32x4 wown[4];
                {
                    float om[2][8];
                    unpack8(raw[8], om[0]); unpack8(raw[9], om[1]);
#pragma unroll
                    for (int hh = 0; hh < 2; ++hh) {
                        wown[hh * 2] = (f32x4){1.f - om[hh][0], 1.f - om[hh][1], 1.f - om[hh][2], 1.f - om[hh][3]};
                        wown[hh * 2 + 1] = (f32x4){1.f - om[hh][4], 1.f - om[hh][5], 1.f - om[hh][6], 1.f - om[hh][7]};
                        *(f32x4*)(Wbuf + li * 64 + c16 + hh * 8) = wown[hh * 2];
                        *(f32x4*)(Wbuf + li * 64 + c16 + hh * 8 + 4) = wown[hh * 2 + 1];
                    }
                }
                asm volatile("" ::: "memory");
                {
                    float wcol[16];
#pragma unroll
                    for (int i = 0; i < 16; ++i) wcol[i] = Wbuf[i * 64 + lane];
                    float Wc = 1.f;
#pragma unroll
                    for (int i = 0; i < 16; ++i) { Wc *= wcol[i]; Wbuf[i * 64 + lane] = Wc; }
                }
                asm volatile("" ::: "memory");
                f32x4 Wv[4], Wm[4], iWv[4];
#pragma unroll
                for (int q4 = 0; q4 < 4; ++q4) {
                    Wv[q4] = *(const f32x4*)(Wbuf + li * 64 + c16 + q4 * 4);
#pragma unroll
                    for (int e = 0; e < 4; ++e) {
                        iWv[q4][e] = __builtin_amdgcn_rcpf(Wv[q4][e]);
                        Wm[q4][e] = li > 0 ? Wv[q4][e] * __builtin_amdgcn_rcpf(wown[q4][e]) : 1.f;
                    }
                }
                asm volatile("" ::: "memory");
                {
                    bf16_t* KbT = (bf16_t*)(slot + SC_KBT); bf16_t* BbT = (bf16_t*)(slot + SC_BBT); bf16_t* VTs = (bf16_t*)(slot + SC_VT);
#pragma unroll
                    for (int hh = 0; hh < 2; ++hh) {
                        float okt[8], ort[8], okh[8], obh[8], rr[8], kx[8], kq[8], av[8];
                        unpack8(hh ? cr1 : cr0, rr); unpack8(hh ? ck1 : ck0, kx); unpack8(hh ? cq1 : cq0, kq); unpack8(hh ? ca1 : ca0, av);
#pragma unroll
                        for (int e = 0; e < 8; ++e) {
                            const int ce = hh * 8 + e, q4 = ce >> 2, qi = ce & 3;
                            const float kd = kx[e] * (1.f + (av[e] - 1.f) * ka16[ce]), bb = kq[e] * av[e];
                            okt[e] = kq[e] * Wm[q4][qi]; ort[e] = rr[e] * Wv[q4][qi];
                            okh[e] = kd * iWv[q4][qi]; obh[e] = bb * iWv[q4][qi];
                        }
                        *(u32x4*)(Kt + li * 72 + c16 + hh * 8) = pack8(okt); *(u32x4*)(Rt + li * 72 + c16 + hh * 8) = pack8(ort);
                        *(u32x4*)(Kh + li * 72 + c16 + hh * 8) = pack8(okh); *(u32x4*)(Bh + li * 72 + c16 + hh * 8) = pack8(obh);
                    }
                    *(u32x4*)(VTs + li * 64 + c16) = vraw0; *(u32x4*)(VTs + li * 64 + c16 + 8) = vraw1;
                    asm volatile("" ::: "memory");
                    const float WC = Wbuf[15 * 64 + lane];
                    float kcol[16], bcol[16]; unsigned vcol[16];
#pragma unroll
                    for (int i = 0; i < 16; ++i) { kcol[i] = bf2f(Kh[i * 72 + lane]) * WC; bcol[i] = bf2f(Bh[i * 72 + lane]) * WC; vcol[i] = VTs[i * 64 + lane]; }
                    asm volatile("" ::: "memory");
                    u32x4 t0, t1;
#pragma unroll
                    for (int e = 0; e < 4; ++e) { t0[e] = cvt_pk_bf16(kcol[2 * e], kcol[2 * e + 1]); t1[e] = cvt_pk_bf16(kcol[8 + 2 * e], kcol[8 + 2 * e + 1]); }
                    *(u32x4*)(KbT + lane * 16) = t0; *(u32x4*)(KbT + lane * 16 + 8) = t1;
#pragma unroll
                    for (int e = 0; e < 4; ++e) { t0[e] = cvt_pk_bf16(bcol[2 * e], bcol[2 * e + 1]); t1[e] = cvt_pk_bf16(bcol[8 + 2 * e], bcol[8 + 2 * e + 1]); }
                    *(u32x4*)(BbT + lane * 16) = t0; *(u32x4*)(BbT + lane * 16 + 8) = t1;
#pragma unroll
                    for (int e = 0; e < 4; ++e) { t0[e] = vcol[2 * e] | (vcol[2 * e + 1] << 16); t1[e] = vcol[8 + 2 * e] | (vcol[8 + 2 * e + 1] << 16); }
                    *(u32x4*)(VTs + lane * 16) = t0; *(u32x4*)(VTs + lane * 16 + 8) = t1;
                    ((float*)(slot + SC_WC))[lane] = WC;
                }
                asm volatile("" ::: "memory");
                if (gg + 1 < NGRP && rp2 == p.rep[14] - 1) SCAN_LOADRAW((gg + 1) * 4 + j);
                const bf16x8 ktx0 = *(const bf16x8*)(Kt + fr * 72 + fq * 8), ktx1 = *(const bf16x8*)(Kt + fr * 72 + 32 + fq * 8);
                const bf16x8 rtx0 = *(const bf16x8*)(Rt + fr * 72 + fq * 8), rtx1 = *(const bf16x8*)(Rt + fr * 72 + 32 + fq * 8);
                const bf16x8 khy0 = *(const bf16x8*)(Kh + fr * 72 + fq * 8), khy1 = *(const bf16x8*)(Kh + fr * 72 + 32 + fq * 8);
                const bf16x8 bhy0 = *(const bf16x8*)(Bh + fr * 72 + fq * 8), bhy1 = *(const bf16x8*)(Bh + fr * 72 + 32 + fq * 8);
                const f32x4 z4 = {0.f, 0.f, 0.f, 0.f};
                f32x4 A = MFMA16(ktx0, bhy0, z4); A = MFMA16(ktx1, bhy1, A);
                f32x4 Bm = MFMA16(ktx0, khy0, z4); Bm = MFMA16(ktx1, khy1, Bm);
                f32x4 E = MFMA16(rtx0, khy0, z4); E = MFMA16(rtx1, khy1, E);
                f32x4 F = MFMA16(rtx0, bhy0, z4); F = MFMA16(rtx1, bhy1, F);
                f32x4 I4, N;
#pragma unroll
                for (int jj = 0; jj < 4; ++jj) {
                    const int i = fq * 4 + jj;
                    I4[jj] = (i == fr) ? 1.f : 0.f;
                    N[jj] = (fr < i) ? -A[jj] : 0.f;
                    Bm[jj] = (fr < i) ? Bm[jj] : 0.f;
                    E[jj] = (fr <= i) ? E[jj] : 0.f;
                    F[jj] = (fr <= i) ? F[jj] : 0.f;
                }
                stD16(P1, I4 + N, fr, fq);
                f32x4 N2 = MFMA16(ldx4z(P1 + fr * 16 + fq * 4), pack4z(N), -N);
                stD16(P2, I4 + N2, fr, fq);
                f32x4 N4 = MFMA16(ldx4z(P2 + fr * 16 + fq * 4), pack4z(N2), -N2);
                stD16(P4, I4 + N4, fr, fq);
                f32x4 N8 = MFMA16(ldx4z(P4 + fr * 16 + fq * 4), pack4z(N4), -N4);
                f32x4 Tm = I4 + N8;
                Tm = MFMA16(ldx4z(P4 + fr * 16 + fq * 4), pack4z(Tm), z4);
                Tm = MFMA16(ldx4z(P2 + fr * 16 + fq * 4), pack4z(Tm), z4);
                Tm = MFMA16(ldx4z(P1 + fr * 16 + fq * 4), pack4z(Tm), z4);
                stD16((bf16_t*)(slot + SC_TM), Tm, fr, fq); stD16((bf16_t*)(slot + SC_BM), Bm, fr, fq);
                stD16((bf16_t*)(slot + SC_E), E, fr, fq); stD16((bf16_t*)(slot + SC_F), F, fr, fq);
            }
        }
        asm volatile("s_waitcnt lgkmcnt(0)" ::: "memory");
        __builtin_amdgcn_s_barrier();
        asm volatile("" ::: "memory");
      }
    } else {
#pragma unroll 1
      for (int g = -1; g < NGRP; ++g) {
        if (g >= 0 && wid < 4) {
#define CONS_LOAD(O, jj_) do { const unsigned char* sl_ = smem + ((g & 1) * 4 + (jj_)) * SC_SLOT; \
                _Pragma("unroll") for (int kt = 0; kt < 4; ++kt) { \
                    O.kt[kt] = *(const bf16x4*)((const bf16_t*)(sl_ + SC_KT) + fr * 72 + kt * 16 + fq * 4); O.rt[kt] = *(const bf16x4*)((const bf16_t*)(sl_ + SC_RT) + fr * 72 + kt * 16 + fq * 4); \
                    O.kb[kt] = *(const bf16x4*)((const bf16_t*)(sl_ + SC_KBT) + (kt * 16 + fr) * 16 + fq * 4); O.bb[kt] = *(const bf16x4*)((const bf16_t*)(sl_ + SC_BBT) + (kt * 16 + fr) * 16 + fq * 4); \
                    O.wc[kt] = *(const f32x4*)((const float*)(sl_ + SC_WC) + kt * 16 + fq * 4); } \
                O.bm = *(const bf16x4*)((const bf16_t*)(sl_ + SC_BM) + fr * 16 + fq * 4); O.e = *(const bf16x4*)((const bf16_t*)(sl_ + SC_E) + fr * 16 + fq * 4); \
                O.tm = *(const bf16x4*)((const bf16_t*)(sl_ + SC_TM) + fr * 16 + fq * 4); O.f = *(const bf16x4*)((const bf16_t*)(sl_ + SC_F) + fr * 16 + fq * 4); \
                O.vy = *(const bf16x4*)((const bf16_t*)(sl_ + SC_VT) + (cw * 32 + fr) * 16 + fq * 4); O.vy2 = *(const bf16x4*)((const bf16_t*)(sl_ + SC_VT) + (cw * 32 + 16 + fr) * 16 + fq * 4); } while (0)
#pragma unroll
            for (int j = 0; j < 4; ++j) {
                ConsOps cur;
                CONS_LOAD(cur, j);
                const int s0 = (g * 4 + j) * 16;
                const int row0 = s0 < 256 ? NLAT + b * 256 + (dir ? 255 - s0 : s0) : b * 4096 + (dir ? 4095 - (s0 - 256) : (s0 - 256));
                const f32x4 z4 = {0.f, 0.f, 0.f, 0.f};
#pragma unroll
                for (int vt = 0; vt < 2; ++vt) {
                    const bf16x8 VY = z8(vt ? cur.vy2 : cur.vy);
                    bf16x8 sb[4]; f32x4 tk[4];
#pragma unroll
                    for (int kt = 0; kt < 4; ++kt) sb[kt] = pack4z(st[vt][kt]);
                    f32x4 X1 = z4, Yo = z4;
#pragma unroll
                    for (int kt = 0; kt < 4; ++kt) X1 = MFMA16(z8(cur.kt[kt]), sb[kt], X1);
                    X1 = MFMA16(z8(cur.bm), VY, X1);
#pragma unroll
                    for (int kt = 0; kt < 4; ++kt) tk[kt] = MFMA16(z8(cur.kb[kt]), VY, st[vt][kt] * cur.wc[kt]);
#pragma unroll
                    for (int kt = 0; kt < 4; ++kt) Yo = MFMA16(z8(cur.rt[kt]), sb[kt], Yo);
                    Yo = MFMA16(z8(cur.e), VY, Yo);
                    const f32x4 U = MFMA16(z8(cur.tm), pack4z(X1), z4);
                    const bf16x8 nUb = pack4z(-U);
#pragma unroll
                    for (int kt = 0; kt < 4; ++kt) st[vt][kt] = MFMA16(z8(cur.bb[kt]), nUb, tk[kt]);
                    Yo = MFMA16(z8(cur.f), nUb, Yo);
#pragma unroll
                    for (int jj = 0; jj < 4; ++jj) {
                        const int row = row0 + (fq * 4 + jj) * rstep;
                        P[(size_t)row * LDP + OFF_RW + dir * 512 + h * 64 + (cw * 2 + vt) * 16 + fr] = f2bf(Yo[jj]);
                    }
                }
            }
#undef CONS_LOAD
        }
        asm volatile("s_waitcnt lgkmcnt(0)" ::: "memory");
        __builtin_amdgcn_s_barrier();
        asm volatile("" ::: "memory");
      }
    }
}

__device__ void phase_readout(const Params& p, int l, int nrows) {
    const int tid_ = otid(); const int lane = tid_ & 63, gw = blockIdx.x * 8 + (tid_ >> 6), nw = gridDim.x * 8;
    const bf16_t* RS = (const bf16_t*)(p.ws + O_H); const bf16_t* KS = RS + (size_t)NTOK * 512;
    const bf16_t* VS = (const bf16_t*)(p.ws + O_VS);
    const bf16_t* AA = (const bf16_t*)(p.ws + O_AA); const bf16_t* GG = (const bf16_t*)(p.ws + O_GG);
    bf16_t* P = (bf16_t*)(p.ws + O_P);
    const int c = lane * 8;
    float gng[8], gnb[8], rk[8], ka[8];
#pragma unroll
    for (int e = 0; e < 8; ++e) { gng[e] = p.in[18][l * 512 + c + e]; gnb[e] = p.in[19][l * 512 + c + e]; rk[e] = p.in[17][l * 512 + c + e]; ka[e] = p.in[16][l * 512 + c + e]; }
#define RO_LOAD(r, D) do { const bf16_t* pr_ = P + (size_t)(r) * LDP + OFF_RW; const size_t o_ = (size_t)(r) * 512 + c; \
        D[0] = *(const u32x4*)(pr_ + c); D[1] = *(const u32x4*)(pr_ + 512 + c); D[2] = *(const u32x4*)(RS + o_); D[3] = *(const u32x4*)(KS + o_); D[4] = *(const u32x4*)(VS + o_); \
        D[5] = *(const u32x4*)(AA + o_); D[6] = *(const u32x4*)(AA + (size_t)NTOK * 512 + o_); D[7] = *(const u32x4*)(GG + o_); } while (0)
    u32x4 nx[8];
    if (gw < nrows) RO_LOAD(gw, nx);
    for (int row = gw; row < nrows; row += nw) {
        bf16_t* pr = P + (size_t)row * LDP + OFF_RW;
        u32x4 cu[8];
#pragma unroll
        for (int i = 0; i < 8; ++i) cu[i] = nx[i];
        if (row + nw < nrows) RO_LOAD(row + nw, nx);
        float y0[8], y1[8], y[8];
        unpack8(cu[0], y0); unpack8(cu[1], y1);
        float s = 0.f;
#pragma unroll
        for (int e = 0; e < 8; ++e) { y[e] = y0[e] + y1[e]; s += y[e]; }
        s += __shfl_xor(s, 1); s += __shfl_xor(s, 2); s += __shfl_xor(s, 4);
        const float mu = s * (1.f / 64.f);
        float qv = 0.f;
#pragma unroll
        for (int e = 0; e < 8; ++e) { y[e] -= mu; qv += y[e] * y[e]; }
        qv += __shfl_xor(qv, 1); qv += __shfl_xor(qv, 2); qv += __shfl_xor(qv, 4);
        const float rs = rsqrtf(qv * (1.f / 64.f) + 64e-5f);
        float r[8], k[8], v[8], a0[8], a1[8], g[8];
        unpack8(cu[2], r); unpack8(cu[3], k); unpack8(cu[4], v);
        unpack8(cu[5], a0); unpack8(cu[6], a1); unpack8(cu[7], g);
        float bon = 0.f;
#pragma unroll
        for (int e = 0; e < 8; ++e) { const float kd = k[e] * (2.f + (a0[e] + a1[e] - 2.f) * ka[e]); bon += r[e] * kd * rk[e]; }
        bon += __shfl_xor(bon, 1); bon += __shfl_xor(bon, 2); bon += __shfl_xor(bon, 4);
        float ov[8];
#pragma unroll
        for (int e = 0; e < 8; ++e) ov[e] = (y[e] * rs * gng[e] + gnb[e] + bon * v[e]) * g[e];
        *(u32x4*)(pr + 1024 + c) = pack8(ov);
    }
}

template <bool CTX>
__device__ __forceinline__ void na_item_t(const Params& p, int l, int item, bool store, const float* rpbL) {
    const int tid = otid(); const int wid = tid >> 6, lane = tid & 63, fr = lane & 15, fq = lane >> 4;
    bf16_t* P = (bf16_t*)(p.ws + O_P);
    const bf16_t* VT = (const bf16_t*)(p.ws + O_VT);
    const int h = wid;
    int b, r = 0, j = 0, tq0, row0 = 0, ks0 = 0;
    if (!CTX) { b = item >> 8; r = (item >> 2) & 63; j = item & 3; tq0 = b * 4096 + r * 64 + j * 16; row0 = min(max(r - 4, 0), 56); ks0 = min(max(16 * j - 8, 0), 32); }
    else { b = item >> 4; tq0 = NLAT + b * 256 + (item & 15) * 16; }
    const bf16_t* qp = P + (size_t)(tq0 + fr) * LDP + OFF_Q + h * 64 + fq * 8;
    const bf16x8 bq0 = *(const bf16x8*)qp, bq1 = *(const bf16x8*)(qp + 32);
    f32x4 sc[32];
    const float* rpb = rpbL + h * 465;
    const int c = j * 16 + fr, kc0 = min(max(c - 8, 0), 48);
    constexpr int T0 = CTX ? 16 : 0;
    const f32x4 z4 = {0.f, 0.f, 0.f, 0.f};
    const int mperm = (fr >> 2) * 8 + (fr & 3);
#pragma unroll
    for (int tg = T0 / 8; tg < 4; ++tg) {
        bf16x8 kf[8][2];
#pragma unroll
        for (int t8 = 0; t8 < 8; ++t8) {
            const int t = tg * 8 + t8, tp = t >> 1, sfx = t & 1;
            const int tok = (tp < 8 ? b * 4096 + (row0 + tp) * 64 + ks0 : NLAT + b * 256 + (tp - 8) * 32) + mperm + sfx * 4;
            const bf16_t* kp = P + (size_t)tok * LDP + OFF_K + h * 64 + fq * 8;
            kf[t8][0] = *(const bf16x8*)kp; kf[t8][1] = *(const bf16x8*)(kp + 32);
        }
#pragma unroll
        for (int t8 = 0; t8 < 8; ++t8) {
            const int t = tg * 8 + t8, tp = t >> 1, sfx = t & 1;
            f32x4 a = MFMA16(kf[t8][0], bq0, z4); a = MFMA16(kf[t8][1], bq1, a);
            if (tp < 8) {
                const float* rp = rpb + (row0 + tp - r + 7) * 31;
#pragma unroll
                for (int jj = 0; jj < 4; ++jj) {
                    const int kc = ks0 + fq * 8 + sfx * 4 + jj;
                    const bool valid = kc >= kc0 && kc < kc0 + 16;
                    const float bias = rp[min(max(kc - c + 15, 0), 30)];
                    a[jj] = valid ? a[jj] * 0.125f + bias : -1e30f;
                }
            } else a = a * 0.125f;
            sc[t] = a;
        }
    }
    float mx = -1e30f;
#pragma unroll
    for (int t = T0; t < 32; ++t)
#pragma unroll
        for (int jj = 0; jj < 4; ++jj) mx = fmaxf(mx, sc[t][jj]);
    mx = fmaxf(mx, __shfl_xor(mx, 16)); mx = fmaxf(mx, __shfl_xor(mx, 32));
    float sum = 0.f;
#pragma unroll
    for (int t = T0; t < 32; ++t)
#pragma unroll
        for (int jj = 0; jj < 4; ++jj) { const float e = __expf(sc[t][jj] - mx); sc[t][jj] = e; sum += e; }
    sum += __shfl_xor(sum, 16); sum += __shfl_xor(sum, 32);
    f32x4 o[4];
#pragma unroll
    for (int dt = 0; dt < 4; ++dt) o[dt] = z4;
#pragma unroll
    for (int tpg = T0 / 8; tpg < 4; ++tpg) {
        bf16x8 vf[4][4];
#pragma unroll
        for (int t4 = 0; t4 < 4; ++t4) {
            const int tp = tpg * 4 + t4;
            const int base = (tp < 8 ? b * 4096 + (row0 + tp) * 64 + ks0 : NLAT + b * 256 + (tp - 8) * 32) + fq * 8;
#pragma unroll
            for (int dt = 0; dt < 4; ++dt) vf[t4][dt] = *(const bf16x8*)(VT + (size_t)(h * 64 + dt * 16 + fr) * NTOK + base);
        }
#pragma unroll
        for (int t4 = 0; t4 < 4; ++t4) {
            const int tp = tpg * 4 + t4;
            BF8 ap;
            ap.u[0] = cvt_pk_bf16(sc[2 * tp][0], sc[2 * tp][1]); ap.u[1] = cvt_pk_bf16(sc[2 * tp][2], sc[2 * tp][3]);
            ap.u[2] = cvt_pk_bf16(sc[2 * tp + 1][0], sc[2 * tp + 1][1]); ap.u[3] = cvt_pk_bf16(sc[2 * tp + 1][2], sc[2 * tp + 1][3]);
#pragma unroll
            for (int dt = 0; dt < 4; ++dt) o[dt] = MFMA16(ap.v, vf[t4][dt], o[dt]);
        }
    }
#pragma unroll
    for (int jj = 0; jj < 4; ++jj) {
        const float sj = __shfl(sum, fq * 4 + jj);
        const float inv = 1.f / sj;
        bf16_t* op = P + (size_t)(tq0 + fq * 4 + jj) * LDP + OFF_Q + h * 64 + fr;
#pragma unroll
        for (int dt = 0; dt < 4; ++dt) if (store) op[dt * 16] = f2bf(o[dt][jj] * inv);
    }
}
__device__ void na_item(const Params& p, int l, int item, bool store, const float* rpbL) {
    if (item < 1024) na_item_t<false>(p, l, item, store, rpbL); else na_item_t<true>(p, l, item - 1024, store, rpbL);
}

constexpr int VLD = 136;
__device__ void sgu_item(const Params& p, int l, int chunk, unsigned char* smem, bool store) {
    const int tid = otid(), wid = tid >> 6, lane = tid & 63, fr = lane & 15, fq = lane >> 4;
    bf16_t* P = (bf16_t*)(p.ws + O_P);
    const bf16_t* SGW = (const bf16_t*)(p.ws + O_SGW) + (size_t)l * 8 * 128 * 128;
    float* stats = (float*)smem;
    bf16_t* VnT = (bf16_t*)(smem + 1024);
    const int rowb = chunk * 128;
    u32x4 sraw[16];
#pragma unroll
    for (int i = 0; i < 16; ++i) sraw[i] = *(const u32x4*)(P + (size_t)(rowb + wid * 16 + i) * LDP + OFF_SG + 512 + lane * 8);
#pragma unroll
    for (int i = 0; i < 16; ++i) {
        const int t = wid * 16 + i;
        float f[8]; unpack8(sraw[i], f);
        float s = 0.f;
#pragma unroll
        for (int e = 0; e < 8; ++e) { f[e] = gelu_tanh(f[e]); s += f[e]; }
#pragma unroll
        for (int o = 1; o < 64; o <<= 1) s += __shfl_xor(s, o);
        const float mu = s * (1.f / 512.f);
        float qv = 0.f;
#pragma unroll
        for (int e = 0; e < 8; ++e) { const float d = f[e] - mu; qv += d * d; }
#pragma unroll
        for (int o = 1; o < 64; o <<= 1) qv += __shfl_xor(qv, o);
        if (lane == 0) { stats[t * 2] = mu; stats[t * 2 + 1] = rsqrtf(qv * (1.f / 512.f) + 1e-5f); }
    }
    __syncthreads();
#pragma unroll 1
    for (int g = 0; g < 8; ++g) {
        {
            const int qq = tid >> 2, cg16 = (tid & 3) * 16;
            const float mu = stats[qq * 2], rs = stats[qq * 2 + 1];
            const bf16_t* vp = P + (size_t)(rowb + qq) * LDP + OFF_SG + 512 + g * 64 + cg16;
#pragma unroll
            for (int hh = 0; hh < 2; ++hh) {
                float f[8]; unpack8(*(const u32x4*)(vp + hh * 8), f);
#pragma unroll
                for (int e = 0; e < 8; ++e) {
                    const int cc = cg16 + hh * 8 + e;
                    const float val = (gelu_tanh(f[e]) - mu) * rs * p.in[20][l * 512 + g * 64 + cc] + p.in[21][l * 512 + g * 64 + cc];
                    VnT[cc * VLD + qq] = f2bf(val);
                }
            }
        }
        __syncthreads();
        {
            const int pp = wid * 16 + fr;
            const bf16_t* wp = SGW + ((size_t)g * 128 + pp) * 128 + fq * 8;
            bf16x8 wf[4];
#pragma unroll
            for (int ks = 0; ks < 4; ++ks) wf[ks] = *(const bf16x8*)(wp + ks * 32);
            const float bs = p.in[23][(l * 8 + g) * 128 + pp];
#pragma unroll
            for (int ct = 0; ct < 4; ++ct) {
                f32x4 acc = {0.f, 0.f, 0.f, 0.f};
#pragma unroll
                for (int ks = 0; ks < 4; ++ks) acc = __builtin_amdgcn_mfma_f32_16x16x32_bf16(*(const bf16x8*)(VnT + (ct * 16 + fr) * VLD + ks * 32 + fq * 8), wf[ks], acc, 0, 0, 0);
                bf16_t* up = P + (size_t)(rowb + pp) * LDP + OFF_SG + g * 64 + ct * 16 + fq * 4;
                float u[4]; unpack4(*(const u32x2*)up, u);
                u32x2 ov;
                ov[0] = cvt_pk_bf16(EN_SGU ? gelu_tanh(u[0]) * (acc[0] + bs) : 0.f, EN_SGU ? gelu_tanh(u[1]) * (acc[1] + bs) : 0.f);
                ov[1] = cvt_pk_bf16(EN_SGU ? gelu_tanh(u[2]) * (acc[2] + bs) : 0.f, EN_SGU ? gelu_tanh(u[3]) * (acc[3] + bs) : 0.f);
                if (store) *(u32x2*)up = ov;
            }
        }
        __syncthreads();
    }
}

#define XB_TMO      128
#define XB_XCNT(j)  (256  + 64 * (j))
#define XB_XSUB(j)  (1280 + 64 * (j))
#define XB_XGEN(j)  (2304 + 64 * (j))
#define XB_TOP      3328
#define XB_TOPGEN   3392
#define XCD_BAR_WORDS 3456
#define XB_SPIN_CAP (1u << 20)
__device__ __forceinline__ unsigned xb_ld(unsigned* p)              { return __hip_atomic_load(p, __ATOMIC_RELAXED, __HIP_MEMORY_SCOPE_AGENT); }
__device__ __forceinline__ unsigned xb_add(unsigned* p, unsigned v) { return __hip_atomic_fetch_add(p, v, __ATOMIC_RELAXED, __HIP_MEMORY_SCOPE_AGENT); }
__device__ __forceinline__ unsigned xb_xcc_id() { return (unsigned)__builtin_amdgcn_s_getreg((3 << 11) | 20) & 0xFu; }
#define XB_SPIN(cond, bar) do { unsigned _sp = 0; while (cond) { __builtin_amdgcn_s_sleep(1); \
    if ((++_sp & 255u) == 0u) { if (xb_ld(&(bar)[XB_TMO])) break; if (_sp > XB_SPIN_CAP) { atomicAdd(&(bar)[XB_TMO], 1u); break; } } } } while (0)
struct XcdBarrier { unsigned* bar; unsigned x; volatile LAS unsigned* st; };
__device__ __forceinline__ XcdBarrier xcd_barrier_post(unsigned* bar, volatile LAS unsigned* st) {
    XcdBarrier b; b.bar = bar; b.x = xb_xcc_id(); b.st = st;
    if (threadIdx.x == 0) (void)xb_add(&bar[XB_XCNT(b.x)], 1u);
    return b;
}
__device__ __forceinline__ void xcd_barrier_complete(unsigned* bar, unsigned x, unsigned& nloc, unsigned& nx) {
    const unsigned G = gridDim.x * gridDim.y * gridDim.z;
    unsigned sum, cnt, mine, sp = 0u;
    for (;;) {
        sum = 0u; cnt = 0u; mine = 0u;
#pragma unroll
        for (unsigned j = 0; j < 16; ++j) { const unsigned c = xb_ld(&bar[XB_XCNT(j)]); sum += c; cnt += (c > 0u) ? 1u : 0u; mine = (j == x) ? c : mine; }
        if (sum == G) break;
        __builtin_amdgcn_s_sleep(1);
        if ((++sp & 255u) == 0u) { if (xb_ld(&bar[XB_TMO])) break; if (sp > XB_SPIN_CAP) { atomicAdd(&bar[XB_TMO], 1u); break; } }
    }
    nloc = mine > 0u ? mine : 1u; nx = cnt > 0u ? cnt : 1u;
}
__device__ __attribute__((noinline)) void xcd_barrier(const XcdBarrier b) {
    asm volatile("s_waitcnt vmcnt(0)" ::: "memory");
    __syncthreads();
    if (threadIdx.x == 0) {
        unsigned* bar = b.bar;
        __builtin_amdgcn_s_waitcnt(0);
        unsigned nloc = b.st[0], nx = b.st[1];
        if (nloc == 0u) { xcd_barrier_complete(bar, b.x, nloc, nx); b.st[0] = nloc; b.st[1] = nx; }
        const unsigned old = xb_add(&bar[XB_XSUB(b.x)], 1u);
        const unsigned gen = old / nloc;
        if (old + 1u == (gen + 1u) * nloc) {
            __builtin_amdgcn_fence(__ATOMIC_RELEASE, "agent");
            asm volatile("s_waitcnt vmcnt(0)" ::: "memory");
            const unsigned og = xb_add(&bar[XB_TOP], 1u);
            const unsigned tg = og / nx;
            if (og + 1u == (tg + 1u) * nx) xb_add(&bar[XB_TOPGEN], 1u);
            else XB_SPIN(xb_ld(&bar[XB_TOPGEN]) == tg, bar);
            __builtin_amdgcn_fence(__ATOMIC_ACQUIRE, "agent");
            xb_add(&bar[XB_XGEN(b.x)], 1u);
            asm volatile("s_waitcnt vmcnt(0)" ::: "memory");
        } else {
            XB_SPIN(xb_ld(&bar[XB_XGEN(b.x)]) == gen, bar);
            __builtin_amdgcn_fence(__ATOMIC_ACQUIRE, "agent");
            asm volatile("s_waitcnt vmcnt(0)" ::: "memory");
        }
    }
    __syncthreads();
}

__global__ void __launch_bounds__(NTHR, 2) fwd_megakernel(Params p) {
    extern __shared__ __attribute__((aligned(16))) unsigned char smem[];
    cg::grid_group grid = cg::this_grid();
    const int G = gridDim.x, bid = blockIdx.x;
    float* ldsf = (float*)smem;
    LAS unsigned char* ldsg = (LAS unsigned char*)smem;
    bf16_t* H = (bf16_t*)(p.ws + O_H);
    bf16_t* P = (bf16_t*)(p.ws + O_P);
    const float* MOD = (const float*)(p.ws + O_MOD);

    unsigned* barw = (unsigned*)(p.ws + O_BAR);
    volatile LAS unsigned* bst = (volatile LAS unsigned*)(ldsg + 131072);
    if (bid == 0) for (int i = threadIdx.x; i < XCD_BAR_WORDS; i += NTHR) barw[i] = 0u;
    if (threadIdx.x < 2) bst[threadIdx.x] = 0u;
    __syncthreads();
    grid.sync();
    (void)xcd_barrier_post(barw, bst);
#define GRID_SYNC() do { XcdBarrier b_; b_.bar = (unsigned*)(p.ws + O_BAR); b_.x = xb_xcc_id(); b_.st = (volatile LAS unsigned*)((LAS unsigned char*)smem + 131072); xcd_barrier(b_); } while (0)
    if (bid < 96) phase_mod(p, ldsf, 0, 1, 0, 96);
    else for (int i = bid - 96; i < 1920 + 320; i += G - 96) { if (i < 1920) conv_win(p, 0, i, ldsf); else conv_small(p, i - 1920, ldsf); }
    GRID_SYNC();
    phase_rows(p, 0, 0, NTOK, true);
    GRID_SYNC();

#pragma unroll 1
    for (int l = 0; l < NL; ++l) {
        const bool lastl = (l == NL - 1);
        const int nMrows = lastl ? NLAT / BM : NTOK / BM;
        const int nrows = lastl ? NLAT : NTOK;
        for (int rp = 0; rp < p.rep[0]; ++rp) {
            GemmDesc g; g.A0 = g.A1 = g.A2 = H; g.B0 = g.B1 = g.B2 = (const bf16_t*)(p.ws + O_WIN); g.lda = DM; g.K = DM;
            TileOrder S; S.init(NTOK / BM, DINP / BM, G, bid, 1);
            EpiP E; E.P = P; E.VT = (bf16_t*)(p.ws + O_VT);
            gemm_phase(ldsg, g, S, E);
        }
        GRID_SYNC();
        for (int rp = 1; rp < p.rep[13]; ++rp) GRID_SYNC();
        for (int rp = 0; rp < p.rep[1]; ++rp) phase_prep(p, l, smem);
        GRID_SYNC();
        if (bid < 64) {
            for (int rp = 0; rp < p.rep[2]; ++rp) scan_chain(p, l, bid, smem);
        } else {
            const int nsgu = lastl ? NLAT / 128 : NTOK / 128;
            const int nna = lastl ? 1024 : 1088;
            for (int rp = 0; rp < p.rep[3]; ++rp)
                for (int i = bid - 64; i < nsgu; i += G - 64) sgu_item(p, l, i, smem, rp == p.rep[3] - 1);
            float* rpbL = ldsf + 8192;
            for (int i = otid(); i < 8 * 465; i += NTHR) rpbL[i] = p.in[7][(size_t)l * 8 * 465 + i];
            __syncthreads();
            for (int rp = 0; rp < p.rep[4]; ++rp)
                for (int i = bid - 64; i < nna; i += G - 64) na_item(p, l, i, rp == p.rep[4] - 1, rpbL);
            __syncthreads();
            if (l == 0) for (int ci = bid - 64; ci < NCONV_LAYER; ci += G - 64) conv_layer(p, 0, ci, ldsf);
        }
        GRID_SYNC();
        for (int rp = 0; rp < p.rep[6]; ++rp) phase_readout(p, l, nrows);
        GRID_SYNC();
        for (int rp = 0; rp < p.rep[7]; ++rp) {
            GemmDesc g; g.A0 = P + OFF_Q; g.A1 = P + OFF_RW + 1024; g.A2 = P + OFF_SG;
            const bf16_t* wb = (const bf16_t*)(p.ws + O_WB); g.B0 = wb; g.B1 = wb + (size_t)DM * 512; g.B2 = wb + (size_t)2 * DM * 512; g.lda = LDP; g.K = 512;
            TileOrder S; S.init(nMrows, DM / BM, G, bid, 3);
            EpiMerge E; E.P = P; E.Y = H;
            gemm_phase(ldsg, g, S, E);
        }
        GRID_SYNC();
        for (int rp = 0; rp < p.rep[8]; ++rp) {
            GemmDesc g; g.A0 = g.A1 = g.A2 = H; g.B0 = g.B1 = g.B2 = (const bf16_t*)(p.ws + O_WOUT); g.lda = DM; g.K = DM;
            TileOrder S; S.init(nMrows, DM / BM, G, bid, 1);
            EpiRes E; E.p = p; E.mod = MOD + (size_t)l * 5 * 6144; E.gidx = 2; E.store = (rp == p.rep[8] - 1);
            gemm_phase(ldsg, g, S, E);
        }
        GRID_SYNC();
        for (int rp = 0; rp < p.rep[9]; ++rp) phase_rows(p, 1, l, nrows, rp == p.rep[9] - 1);
        GRID_SYNC();
        for (int rp = 0; rp < p.rep[10]; ++rp) {
            GemmDesc g; g.A0 = g.A1 = g.A2 = H; g.B0 = g.B1 = g.B2 = (const bf16_t*)(p.ws + O_WGU); g.lda = DM; g.K = DM;
            TileOrder S; S.init(nMrows, 2 * DFF / BM, G, bid, 1);
            EpiGlu E; E.HID = P;
            gemm_phase(ldsg, g, S, E);
        }
        GRID_SYNC();
        for (int rp = 0; rp < p.rep[11]; ++rp) {
            GemmDesc g; g.A0 = g.A1 = g.A2 = P; g.B0 = g.B1 = g.B2 = (const bf16_t*)(p.ws + O_WDN) + (size_t)(l & 1) * DM * DFF; g.lda = DFF; g.K = DFF;
            TileOrder S; S.init(nMrows, DM / BM, G, bid, 1);
            EpiRes E; E.p = p; E.mod = MOD + (size_t)l * 5 * 6144; E.gidx = 5; E.store = (rp == p.rep[11] - 1);
            gemm_phase(ldsg, g, S, E);
        }
        if (!lastl && bid >= 16) {
            if (bid < 112) phase_mod(p, ldsf, l + 1, 1, 16, 96);
            else for (int rp = 0; rp < p.rep[5]; ++rp)
                for (int ci = bid - 112; ci < NCONV_LAYER + 1920; ci += G - 112) { if (ci < NCONV_LAYER) conv_layer(p, l + 1, ci, ldsf); else conv_win(p, l + 1, ci - NCONV_LAYER, ldsf); }
        }
        GRID_SYNC();
        for (int rp = 0; rp < p.rep[12]; ++rp) phase_rows(p, 2, l, nrows, rp == p.rep[12] - 1);
        GRID_SYNC();
    }
}

extern "C" void kernel_launch(void* const* d_in, const int* in_sizes, int n_in, void* d_out, int out_size, void* d_ws, size_t ws_size, hipStream_t stream) {
    static int grid_blocks = 0;
    if (!grid_blocks) {
        int dev = 0, cus = 0, per_cu = 0;
        hipGetDevice(&dev);
        hipDeviceGetAttribute(&cus, hipDeviceAttributeMultiprocessorCount, dev);
        hipFuncSetAttribute((const void*)fwd_megakernel, hipFuncAttributeMaxDynamicSharedMemorySize, SMEM_BYTES);
        hipOccupancyMaxActiveBlocksPerMultiprocessor(&per_cu, fwd_megakernel, NTHR, SMEM_BYTES);
        if (per_cu < 1) per_cu = 1;
        if (per_cu > 1) per_cu = 1;
        grid_blocks = cus * per_cu;
    }
    if (ws_size < WS_TOTAL) { fprintf(stderr, "workspace too small: %zu < %zu\n", ws_size, (size_t)WS_TOTAL); return; }
    Params p{};
    for (int i = 0; i < 32; ++i) p.in[i] = (const float*)d_in[i];
    p.out = (float*)d_out;
    p.ws = (unsigned char*)d_ws;
    for (int i = 0; i < 16; ++i) p.rep[i] = 1;
#ifdef REPK
    p.rep[REPK] = 2;
#endif
    void* args[] = {&p};
    hipError_t e = hipLaunchCooperativeKernel((void*)fwd_megakernel, dim3(grid_blocks), dim3(NTHR), args, SMEM_BYTES, stream);
    if (e != hipSuccess) fprintf(stderr, "cooperative launch failed: %s (grid %d)\n", hipGetErrorString(e), grid_blocks);
}
```

```cpp
#include <hip/hip_runtime.h>
#include <hip/hip_cooperative_groups.h>
#include <cstdio>
namespace cg = cooperative_groups;

#define LAS __attribute__((address_space(3)))
typedef unsigned short bf16_t;
typedef short bf16x8 __attribute__((ext_vector_type(8)));
typedef short bf16x4 __attribute__((ext_vector_type(4)));
typedef float f32x4 __attribute__((ext_vector_type(4)));
typedef unsigned u32x4 __attribute__((ext_vector_type(4)));
typedef unsigned u32x2 __attribute__((ext_vector_type(2)));

#ifndef EN_NA
#define EN_NA 1
#endif
#ifndef EN_RWKV
#define EN_RWKV 1
#endif
#ifndef EN_SGU
#define EN_SGU 1
#endif
#ifndef EN_MIX
#define EN_MIX 1
#endif
#ifndef EN_FFN
#define EN_FFN 1
#endif

constexpr int DM = 1024, NB = 4, SEQ = 4096, NL = 4, CTXL = 256;
constexpr int NLAT = NB * SEQ, NCTX = NB * CTXL, NTOK = NLAT + NCTX;
constexpr int DIN = 7552, DINP = 7680, LDP = 7552;
constexpr int OFF_Q = 3072, OFF_K = 3584, OFF_V = 4096, OFF_RW = 4608, OFF_SG = 6528;
constexpr int DFF = 2816;
constexpr float ALPHA = 1.681792830507429f;
constexpr int NTHR = 512;
constexpr int SMEM_BYTES = 131072 + 16;

constexpr size_t SZ_TOK512 = (size_t)NTOK * 512 * 2;
constexpr size_t O_XC = 0;
constexpr size_t O_MOD = O_XC + (size_t)NCTX * DM * 4;
constexpr size_t O_H = O_MOD + (size_t)NL * 5 * 6144 * 4;
constexpr size_t O_P = O_H + (size_t)NTOK * DM * 2;
constexpr size_t O_WIN = O_P + (size_t)NTOK * LDP * 2;
constexpr size_t O_WB = O_WIN + (size_t)DINP * DM * 2;
constexpr size_t O_WOUT = O_WB + (size_t)3 * DM * 512 * 2;
constexpr size_t O_WGU = O_WOUT + (size_t)DM * DM * 2;
constexpr size_t O_WDN = O_WGU + (size_t)2 * DFF * DM * 2;
constexpr size_t O_W2T = O_WDN + (size_t)2 * DM * DFF * 2;
constexpr size_t O_A2T = O_W2T + (size_t)NL * 2 * 512 * 64 * 2;
constexpr size_t O_G2T = O_A2T + (size_t)NL * 2 * 512 * 64 * 2;
constexpr size_t O_SGW = O_G2T + (size_t)NL * 512 * 128 * 2;
constexpr size_t O_VT = O_SGW + (size_t)NL * 8 * 128 * 128 * 2;
constexpr size_t O_VS = O_VT + SZ_TOK512;
constexpr size_t O_KK = O_VS + SZ_TOK512;
constexpr size_t O_OMD = O_KK + SZ_TOK512;
constexpr size_t O_AA = O_OMD + 2 * SZ_TOK512;
constexpr size_t O_GG = O_AA + 2 * SZ_TOK512;
constexpr size_t O_BAR = O_GG + SZ_TOK512;
constexpr size_t WS_TOTAL = O_BAR + 16384;
static_assert(WS_TOTAL <= 494927872ull, "workspace too large");

struct Params {
    const float* in[32];
    float* out;
    unsigned char* ws;
    int rep[16];
};

__device__ __forceinline__ int otid() { int t = threadIdx.x; asm volatile("" : "+v"(t)); return t; }
__device__ __forceinline__ float bf2f(bf16_t b) { return __uint_as_float(((unsigned)b) << 16); }
typedef __bf16 bf16v2_t __attribute__((ext_vector_type(2)));
typedef float f32v2_t __attribute__((ext_vector_type(2)));
__device__ __forceinline__ unsigned cvt_pk_bf16(float lo, float hi) { const f32v2_t f = {lo, hi}; const bf16v2_t b = __builtin_convertvector(f, bf16v2_t); return __builtin_bit_cast(unsigned, b); }
__device__ __forceinline__ bf16_t f2bf(float f) { return (bf16_t)(cvt_pk_bf16(f, 0.f) & 0xffffu); }
__device__ __forceinline__ void unpack8(const u32x4 v, float (&f)[8]) {
#pragma unroll
    for (int i = 0; i < 4; ++i) { f[2 * i] = __uint_as_float(v[i] << 16); f[2 * i + 1] = __uint_as_float(v[i] & 0xffff0000u); }
}
__device__ __forceinline__ u32x4 pack8(const float (&f)[8]) {
    u32x4 r;
#pragma unroll
    for (int i = 0; i < 4; ++i) r[i] = cvt_pk_bf16(f[2 * i], f[2 * i + 1]);
    return r;
}
__device__ __forceinline__ void unpack4(const u32x2 v, float (&f)[4]) {
    f[0] = __uint_as_float(v[0] << 16); f[1] = __uint_as_float(v[0] & 0xffff0000u);
    f[2] = __uint_as_float(v[1] << 16); f[3] = __uint_as_float(v[1] & 0xffff0000u);
}
__device__ __forceinline__ float sigmoidf_(float x) { return __builtin_amdgcn_rcpf(1.f + __expf(-x)); }
__device__ __forceinline__ float gelu_tanh(float x) { const float y = 0.7978845608028654f * (x + 0.044715f * x * x * x); return x / (1.f + __expf(-2.f * y)); }
__device__ __forceinline__ float* xrow(const Params& p, int row) { return row < NLAT ? p.out + (size_t)row * DM : (float*)(p.ws + O_XC) + (size_t)(row - NLAT) * DM; }
__device__ __forceinline__ int mod_batch(int row) { return row < NLAT ? (row >> 12) : 4; }

constexpr int BM = 256, BK = 64, HALF = 128, HTB = HALF * BK * 2, NXCD = 8, WGM = 8;
__device__ __forceinline__ int lds_byte(int r, int c) { const int st = (r >> 4) * 2 + (c >> 5), rr = r & 15, cc = c & 31, ob = rr * 64 + cc * 2; return st * 1024 + (ob ^ (((ob >> 9) & 1) << 5)); }
__device__ __forceinline__ void stage_rc(int b, int& R, int& C) { const int st = b / 1024, sb = b % 1024, swz = sb ^ (((sb >> 9) & 1) << 5); R = (st >> 1) * 16 + swz / 64; C = (st & 1) * 32 + (swz % 64) / 2; }
__device__ __forceinline__ int perm32(int rho) { const int n = rho >> 4, i = rho & 15; return 8 * (i >> 2) + 4 * n + (i & 3); }

struct Unit { int pm, pn, z; };
struct GemmDesc { const bf16_t* A0; const bf16_t* A1; const bf16_t* A2; const bf16_t* B0; const bf16_t* B1; const bf16_t* B2; int lda, K; };

struct TileOrder {
    int nM, nN, nwg, G, c, nz;
    __device__ void init(int nM_, int nN_, int G_, int c_, int nz_) { nM = nM_; nN = nN_; nwg = nM * nN; G = G_; c = c_; nz = nz_; }
    __device__ bool next(int i, Unit& u) const {
        const int it = i / nz; u.z = i - it * nz;
        const long L = (long)it * G + c; if (L >= nwg) return false;
        int wgid = (int)L; { const int q = nwg / NXCD, r = nwg % NXCD, xcd = wgid % NXCD, off = wgid / NXCD; wgid = (xcd < r ? xcd * (q + 1) : r * (q + 1) + (xcd - r) * q) + off; }
        const int nig = WGM * nN, gid = wgid / nig, fm = gid * WGM, gsz = (nM - fm) < WGM ? (nM - fm) : WGM;
        u.pm = fm + ((wgid % nig) % gsz); u.pn = (wgid % nig) / gsz; return true;
    }
};

typedef f32x4 Acc[2][2][4][2];
__device__ __forceinline__ void zero_acc(Acc& acc) {
#pragma unroll
    for (int a = 0; a < 2; ++a)
#pragma unroll
        for (int b = 0; b < 2; ++b)
#pragma unroll
            for (int m = 0; m < 4; ++m)
#pragma unroll
                for (int n = 0; n < 2; ++n) acc[a][b][m][n] = (f32x4){0.f, 0.f, 0.f, 0.f};
}

struct EpiP {
    static constexpr bool PERM = true;
    bf16_t* P; bf16_t* VT;
    __device__ __forceinline__ void operator()(Acc& acc, const Unit& u, int wr, int wc, int fr, int fq) const {
        const int row0 = u.pm * BM + wr * 64 + fr, colb = u.pn * BM + wc * 32 + 8 * fq;
        const bool isv = (u.pn == 16 || u.pn == 17);
#pragma unroll
        for (int ai = 0; ai < 2; ++ai)
#pragma unroll
            for (int m = 0; m < 4; ++m) {
                const int row = row0 + ai * HALF + m * 16;
#pragma unroll
                for (int bj = 0; bj < 2; ++bj) {
                    const int col = colb + bj * HALF;
                    const f32x4 v0 = acc[ai][bj][m][0], v1 = acc[ai][bj][m][1];
                    u32x4 o; o[0] = cvt_pk_bf16(v0[0], v0[1]); o[1] = cvt_pk_bf16(v0[2], v0[3]); o[2] = cvt_pk_bf16(v1[0], v1[1]); o[3] = cvt_pk_bf16(v1[2], v1[3]);
                    if (col < DIN) *(u32x4*)(P + (size_t)row * LDP + col) = o;
                    if (isv) {
                        bf16_t* vt = VT + (size_t)(col - OFF_V) * NTOK + row;
#pragma unroll
                        for (int e = 0; e < 4; ++e) { vt[(size_t)(2 * e) * NTOK] = (bf16_t)(o[e] & 0xffffu); vt[(size_t)(2 * e + 1) * NTOK] = (bf16_t)(o[e] >> 16); }
                    }
                }
            }
        zero_acc(acc);
    }
};

struct EpiMerge {
    static constexpr bool PERM = true;
    const bf16_t* P; bf16_t* Y;
    __device__ __forceinline__ void operator()(Acc& acc, const Unit& u, int wr, int wc, int fr, int fq) const {
        const int row0 = u.pm * BM + wr * 64 + fr, colb = u.pn * BM + wc * 32 + 8 * fq;
        const int zb = u.z < 2 ? 1024 : 0;
#pragma unroll
        for (int ai = 0; ai < 2; ++ai) {
            u32x4 ga[4][2], gb[4][2];
#pragma unroll
            for (int m = 0; m < 4; ++m)
#pragma unroll
                for (int bj = 0; bj < 2; ++bj) {
                    const bf16_t* gp = P + (size_t)(row0 + ai * HALF + m * 16) * LDP + u.z * 1024 + colb + bj * HALF;
                    ga[m][bj] = *(const u32x4*)gp; gb[m][bj] = *(const u32x4*)(gp + zb);
                }
#pragma unroll
            for (int m = 0; m < 4; ++m)
#pragma unroll
                for (int bj = 0; bj < 2; ++bj) {
                    float fa[8], fb[8], sc[8];
                    unpack8(ga[m][bj], fa); unpack8(gb[m][bj], fb);
#pragma unroll
                    for (int e = 0; e < 8; ++e) { const float ra = __builtin_amdgcn_rcpf(1.f + __expf(-fa[e])); sc[e] = u.z < 2 ? (1.f + __expf(-fb[e])) * ra : ra; }
                    f32x4 v0 = acc[ai][bj][m][0], v1 = acc[ai][bj][m][1];
#pragma unroll
                    for (int e = 0; e < 4; ++e) { v0[e] *= sc[e]; v1[e] *= sc[4 + e]; }
                    if (u.z == 2) {
                        u32x4 o; o[0] = cvt_pk_bf16(v0[0], v0[1]); o[1] = cvt_pk_bf16(v0[2], v0[3]); o[2] = cvt_pk_bf16(v1[0], v1[1]); o[3] = cvt_pk_bf16(v1[2], v1[3]);
                        *(u32x4*)(Y + (size_t)(row0 + ai * HALF + m * 16) * DM + colb + bj * HALF) = o;
                        acc[ai][bj][m][0] = (f32x4){0.f, 0.f, 0.f, 0.f}; acc[ai][bj][m][1] = (f32x4){0.f, 0.f, 0.f, 0.f};
                    } else { acc[ai][bj][m][0] = v0; acc[ai][bj][m][1] = v1; }
                }
        }
    }
};

struct EpiRes {
    static constexpr bool PERM = false;
    Params p; const float* mod;
    int gidx; bool store;
    __device__ __forceinline__ void operator()(Acc& acc, const Unit& u, int wr, int wc, int fr, int fq) const {
        const int row0 = u.pm * BM + wr * 64 + fr, colb = u.pn * BM + wc * 32 + 4 * fq;
        const float* gm = mod + mod_batch(u.pm * BM) * 6144 + gidx * 1024;
        f32x4 gv[2][2];
#pragma unroll
        for (int bj = 0; bj < 2; ++bj)
#pragma unroll
            for (int n = 0; n < 2; ++n) gv[bj][n] = *(const f32x4*)(gm + colb + bj * HALF + n * 16);
#pragma unroll
        for (int ai = 0; ai < 2; ++ai) {
            f32x4 xv[4][2][2];
#pragma unroll
            for (int m = 0; m < 4; ++m) {
                const float* rp = xrow(p, row0 + ai * HALF + m * 16) + colb;
#pragma unroll
                for (int bj = 0; bj < 2; ++bj)
#pragma unroll
                    for (int n = 0; n < 2; ++n) xv[m][bj][n] = *(const f32x4*)(rp + bj * HALF + n * 16);
            }
#pragma unroll
            for (int m = 0; m < 4; ++m) {
                float* rp = xrow(p, row0 + ai * HALF + m * 16) + colb;
#pragma unroll
                for (int bj = 0; bj < 2; ++bj)
#pragma unroll
                    for (int n = 0; n < 2; ++n) if (store) *(f32x4*)(rp + bj * HALF + n * 16) = xv[m][bj][n] * ALPHA + gv[bj][n] * acc[ai][bj][m][n];
            }
        }
        zero_acc(acc);
    }
};

struct EpiGlu {
    static constexpr bool PERM = true;
    bf16_t* HID;
    __device__ __forceinline__ void operator()(Acc& acc, const Unit& u, int wr, int wc, int fr, int fq) const {
        const int row0 = u.pm * BM + wr * 64 + fr, col = u.pn * HALF + wc * 32 + 8 * fq;
#pragma unroll
        for (int ai = 0; ai < 2; ++ai)
#pragma unroll
            for (int m = 0; m < 4; ++m) {
                const int row = row0 + ai * HALF + m * 16;
                float o[8];
#pragma unroll
                for (int n = 0; n < 2; ++n)
#pragma unroll
                    for (int e = 0; e < 4; ++e) { const float g = acc[ai][0][m][n][e], up = acc[ai][1][m][n][e]; o[n * 4 + e] = g * __builtin_amdgcn_rcpf(1.f + __expf(-g)) * up; }
                *(u32x4*)(HID + (size_t)row * DFF + col) = pack8(o);
            }
        zero_acc(acc);
    }
};

template <class Epi>
__device__ __forceinline__ void gemm_phase(LAS unsigned char* lds, const GemmDesc g, const TileOrder& S, const Epi& E) {
    const int tid = otid(), wid = __builtin_amdgcn_readfirstlane(tid >> 6), lane = tid & 63, wr = wid >> 2, wc = wid & 3, fr = lane & 15, fq = lane >> 4;
    const int K = g.K, nt = K / BK, lda = g.lda;
    unsigned voffA[2], voffB[2];
#pragma unroll
    for (int i = 0; i < 2; ++i) { int R, C; stage_rc(tid * 16 + i * 8192, R, C); const int Rb = Epi::PERM ? ((R & ~31) + perm32(R & 31)) : R;
        voffA[i] = (unsigned)(R * lda + C) * 2u; voffB[i] = (unsigned)(Rb * K + C) * 2u; }
    const size_t kstep = (size_t)(BK * 2);
    const size_t hstepA = (size_t)HALF * lda * 2, hstepB = (size_t)HALF * K * 2;
    const size_t tstepA = 2 * hstepA, tstepB = 2 * hstepB;
    const unsigned ldsw = (unsigned)wid * 1024u;
    const int aoff = lds_byte(wr * 64 + fr, fq * 8), boff = lds_byte(wc * 32 + fr, fq * 8);
#define PG8_SA(b, h) (((b) * 2 + (h)) * HTB)
#define PG8_SB(b, h) ((4 + (b) * 2 + (h)) * HTB)
#define PG8_STAGE(bufoff, gbase, voff) do { _Pragma("unroll") for (int _i = 0; _i < 2; ++_i) \
        __builtin_amdgcn_global_load_lds((const unsigned*)((const char*)(gbase) + (voff)[_i]), (LAS unsigned*)(lds + (bufoff) + ldsw + _i * 8192), 16, 0, 0); } while (0)
#define PG8_LDA(dst, b, h) do { _Pragma("unroll") for (int m = 0; m < 4; ++m) _Pragma("unroll") for (int k = 0; k < 2; ++k) dst[m][k] = *(const LAS bf16x8*)(lds + PG8_SA(b, h) + aoff + m * 2048 + k * 1024); } while (0)
#define PG8_LDB(dst, b, h) do { _Pragma("unroll") for (int n = 0; n < 2; ++n) _Pragma("unroll") for (int k = 0; k < 2; ++k) dst[n][k] = *(const LAS bf16x8*)(lds + PG8_SB(b, h) + boff + n * 2048 + k * 1024); } while (0)
#define PG8_MMA(ai, bj, At, Bt) do { __builtin_amdgcn_s_setprio(1); _Pragma("unroll") for (int m = 0; m < 4; ++m) _Pragma("unroll") for (int n = 0; n < 2; ++n) _Pragma("unroll") for (int k = 0; k < 2; ++k) \
        acc[ai][bj][m][n] = __builtin_amdgcn_mfma_f32_16x16x32_bf16(Bt[n][k], At[m][k], acc[ai][bj][m][n], 0, 0, 0); __builtin_amdgcn_s_setprio(0); } while (0)
#define PG8_WAIT_V(n) asm volatile("s_waitcnt vmcnt(" #n ")" ::: "memory")
#define PG8_WAIT_L(n) asm volatile("s_waitcnt lgkmcnt(" #n ")" ::: "memory")
#define PG8_BAR __builtin_amdgcn_s_barrier()
#define PG8_SCHED __builtin_amdgcn_sched_barrier(0)
    Unit cur, nxt; int ui = 0;
    if (!S.next(0, cur)) return;
    Acc acc;
    zero_acc(acc);
    bf16x8 At[4][2], B0[2][2], B1[2][2];
    const char* cA = (const char*)(cur.z == 0 ? g.A0 : cur.z == 1 ? g.A1 : g.A2) + (size_t)cur.pm * tstepA;
    const char* cB = (const char*)(cur.z == 0 ? g.B0 : cur.z == 1 ? g.B1 : g.B2) + (size_t)cur.pn * tstepB;
    PG8_STAGE(PG8_SB(0, 0), cB, voffB); PG8_STAGE(PG8_SB(0, 1), cB + hstepB, voffB); PG8_STAGE(PG8_SA(0, 0), cA, voffA); PG8_STAGE(PG8_SA(0, 1), cA + hstepA, voffA);
    if (wr == 1) PG8_BAR;
    PG8_WAIT_V(2); PG8_BAR;
    PG8_STAGE(PG8_SB(1, 0), cB + kstep, voffB); PG8_STAGE(PG8_SA(1, 0), cA + kstep, voffA); PG8_STAGE(PG8_SB(1, 1), cB + hstepB + kstep, voffB);
    PG8_WAIT_V(6); PG8_BAR;
    for (;;) {
        const bool has_next = S.next(ui + 1, nxt);
        const char* nA = has_next ? (const char*)(nxt.z == 0 ? g.A0 : nxt.z == 1 ? g.A1 : g.A2) + (size_t)nxt.pm * tstepA : cA;
        const char* nB = has_next ? (const char*)(nxt.z == 0 ? g.B0 : nxt.z == 1 ? g.B1 : g.B2) + (size_t)nxt.pn * tstepB : cB;
        for (int t = 0; t < nt; t += 2) {
            const bool last = (t == nt - 2);
            const char* a1 = cA + (size_t)(t + 1) * kstep;
            const char* a2 = last ? nA : cA + (size_t)(t + 2) * kstep; const char* b2 = last ? nB : cB + (size_t)(t + 2) * kstep;
            const char* a3 = a2 + kstep; const char* b3 = b2 + kstep;
            PG8_LDB(B0, 0, 0); PG8_LDB(B1, 0, 1); PG8_SCHED; PG8_LDA(At, 0, 0); PG8_STAGE(PG8_SA(1, 1), a1 + hstepA, voffA);
            PG8_WAIT_V(8); PG8_WAIT_L(0); PG8_BAR; PG8_MMA(0, 0, At, B0); PG8_MMA(0, 1, At, B1); PG8_BAR; PG8_SCHED;
            PG8_LDA(At, 0, 1); PG8_STAGE(PG8_SB(0, 0), b2, voffB); PG8_STAGE(PG8_SB(0, 1), b2 + hstepB, voffB); PG8_STAGE(PG8_SA(0, 0), a2, voffA);
            PG8_WAIT_V(8); PG8_WAIT_L(0); PG8_BAR; PG8_MMA(1, 0, At, B0); PG8_MMA(1, 1, At, B1); PG8_BAR; PG8_SCHED;
            PG8_LDB(B0, 1, 0); PG8_LDB(B1, 1, 1); PG8_SCHED; PG8_LDA(At, 1, 0); PG8_STAGE(PG8_SA(0, 1), a2 + hstepA, voffA);
            PG8_WAIT_V(8); PG8_WAIT_L(0); PG8_BAR; PG8_MMA(0, 0, At, B0); PG8_MMA(0, 1, At, B1); PG8_BAR; PG8_SCHED;
            PG8_LDA(At, 1, 1); PG8_STAGE(PG8_SB(1, 0), b3, voffB); PG8_STAGE(PG8_SB(1, 1), b3 + hstepB, voffB); PG8_STAGE(PG8_SA(1, 0), a3, voffA);
            PG8_WAIT_V(8); PG8_WAIT_L(0); PG8_BAR; PG8_MMA(1, 0, At, B0); PG8_MMA(1, 1, At, B1); PG8_BAR; PG8_SCHED;
        }
        if (wr == 0) PG8_BAR;
        E(acc, cur, wr, wc, fr, fq);
        if (!has_next) break;
        cur = nxt; cA = nA; cB = nB; ++ui;
        if (wr == 1) PG8_BAR;
    }
    PG8_WAIT_V(0);
    PG8_BAR;
#undef PG8_SA
#undef PG8_SB
#undef PG8_STAGE
#undef PG8_LDA
#undef PG8_LDB
#undef PG8_MMA
#undef PG8_WAIT_V
#undef PG8_WAIT_L
#undef PG8_BAR
#undef PG8_SCHED
}

__device__ void phase_mod(const Params& p, float* lds, int l0, int nl, int b0, int nb) {
    const int tid = otid();
    for (int i = tid; i < 5 * 1024; i += NTHR) { const float c = i < 4096 ? p.in[1][i] : p.in[3][i - 4096]; lds[i] = c / (1.f + __expf(-c)); }
    __syncthreads();
    float* red = lds + 5 * 1024;
    float* MOD = (float*)(p.ws + O_MOD);
    const int col = tid & 63, kp = tid >> 6;
    for (int item = (int)blockIdx.x - b0; item < nl * 96; item += nb) {
        const int l = l0 + item / 96, j0 = (item % 96) * 64;
        const float* w = p.in[4] + ((size_t)l * 1024 + kp * 128) * 6144 + j0 + col;
        float a0 = 0.f, a1 = 0.f, a2 = 0.f, a3 = 0.f, a4 = 0.f;
        const float* s = lds + kp * 128;
#pragma unroll 16
        for (int k = 0; k < 128; ++k) { const float wv = w[(size_t)k * 6144]; a0 += s[k] * wv; a1 += s[1024 + k] * wv; a2 += s[2048 + k] * wv; a3 += s[3072 + k] * wv; a4 += s[4096 + k] * wv; }
        red[(kp * 5 + 0) * 64 + col] = a0; red[(kp * 5 + 1) * 64 + col] = a1; red[(kp * 5 + 2) * 64 + col] = a2; red[(kp * 5 + 3) * 64 + col] = a3; red[(kp * 5 + 4) * 64 + col] = a4;
        __syncthreads();
        if (tid < 320) {
            const int s5 = tid >> 6, cc = tid & 63;
            float v = p.in[5][l * 6144 + j0 + cc];
#pragma unroll
            for (int q = 0; q < 8; ++q) v += red[(q * 5 + s5) * 64 + cc];
            MOD[((size_t)l * 5 + s5) * 6144 + j0 + cc] = v;
        }
        __syncthreads();
    }
}

struct ConvJob { const float* src; bf16_t* dst; int K, ldsrc, nvalid, mode; };
__device__ void conv_tile(const ConvJob& j, int kt, int ntile, float* lds) {
    const int tid = otid();
    const int k0 = kt * 64, n0 = ntile * 64;
    int scol = n0; bool valid = n0 < j.nvalid;
    if (j.mode == 1) { const int pn = n0 >> 8, bj = (n0 >> 7) & 1, j0 = n0 & 127; scol = bj * DFF + pn * 128 + j0; }
    {
        const int r = tid >> 3, c8 = (tid & 7) * 8;
        f32x4 v0 = {0.f, 0.f, 0.f, 0.f}, v1 = {0.f, 0.f, 0.f, 0.f};
        if (valid) { const float* sp = j.src + (size_t)(k0 + r) * j.ldsrc + scol + c8; v0 = *(const f32x4*)sp; v1 = *(const f32x4*)(sp + 4); }
        float* t = lds + r * 65 + c8;
        t[0] = v0[0]; t[1] = v0[1]; t[2] = v0[2]; t[3] = v0[3]; t[4] = v1[0]; t[5] = v1[1]; t[6] = v1[2]; t[7] = v1[3];
    }
    __syncthreads();
    {
        const int n = tid >> 3, k8 = (tid & 7) * 8;
        float f[8];
#pragma unroll
        for (int e = 0; e < 8; ++e) f[e] = lds[(k8 + e) * 65 + n];
        *(u32x4*)(j.dst + (size_t)(n0 + n) * j.K + k0 + k8) = pack8(f);
    }
    __syncthreads();
}
__device__ void conv_win(const Params& p, int l, int idx, float* lds) {
    ConvJob j; j.src = p.in[6] + (size_t)l * DM * DIN; j.dst = (bf16_t*)(p.ws + O_WIN); j.K = DM; j.ldsrc = DIN; j.nvalid = DIN; j.mode = 0;
    conv_tile(j, idx & 15, idx >> 4, lds);
}
__device__ void conv_small(const Params& p, int idx, float* lds) {
    const int tid = otid();
    if (idx < 128) {
        const int which = idx >> 6, r = idx & 63, ld = r >> 3, ntile = r & 7;
        ConvJob j; j.src = p.in[which ? 13 : 11] + (size_t)ld * 64 * 512; j.dst = (bf16_t*)(p.ws + (which ? O_A2T : O_W2T)) + (size_t)ld * 512 * 64; j.K = 64; j.ldsrc = 512; j.nvalid = 512; j.mode = 0;
        conv_tile(j, 0, ntile, lds);
    } else if (idx < 192) {
        const int r = idx - 128, l = r >> 4, kt = (r >> 3) & 1, ntile = r & 7;
        ConvJob j; j.src = p.in[14] + (size_t)l * 128 * 512; j.dst = (bf16_t*)(p.ws + O_G2T) + (size_t)l * 512 * 128; j.K = 128; j.ldsrc = 512; j.nvalid = 512; j.mode = 0;
        conv_tile(j, kt, ntile, lds);
    } else {
        const int r = idx - 192;
        const float* s = p.in[22] + (size_t)r * 4096 + tid * 8;
        float f[8]; const f32x4 v0 = *(const f32x4*)s, v1 = *(const f32x4*)(s + 4);
        f[0] = v0[0]; f[1] = v0[1]; f[2] = v0[2]; f[3] = v0[3]; f[4] = v1[0]; f[5] = v1[1]; f[6] = v1[2]; f[7] = v1[3];
        *(u32x4*)((bf16_t*)(p.ws + O_SGW) + (size_t)r * 4096 + tid * 8) = pack8(f);
    }
}
constexpr int NCONV_LAYER = 384 + 256 + 1408 + 704;
__device__ void conv_layer(const Params& p, int l, int idx, float* lds) {
    ConvJob j; j.mode = 0;
    if (idx < 384) { const int br = idx >> 7, r = idx & 127; j.src = p.in[24] + ((size_t)l * 3 + br) * 512 * DM; j.dst = (bf16_t*)(p.ws + O_WB) + (size_t)br * DM * 512; j.K = 512; j.ldsrc = DM; j.nvalid = DM; conv_tile(j, r & 7, r >> 3, lds); return; }
    idx -= 384;
    if (idx < 256) { j.src = p.in[25] + (size_t)l * DM * DM; j.dst = (bf16_t*)(p.ws + O_WOUT); j.K = DM; j.ldsrc = DM; j.nvalid = DM; conv_tile(j, idx & 15, idx >> 4, lds); return; }
    idx -= 256;
    if (idx < 1408) { j.src = p.in[30] + (size_t)l * DM * 2 * DFF; j.dst = (bf16_t*)(p.ws + O_WGU); j.K = DM; j.ldsrc = 2 * DFF; j.nvalid = 2 * DFF; j.mode = 1; conv_tile(j, idx & 15, idx >> 4, lds); return; }
    idx -= 1408;
    { j.src = p.in[31] + (size_t)l * DFF * DM; j.dst = (bf16_t*)(p.ws + O_WDN) + (size_t)(l & 1) * DM * DFF; j.K = DFF; j.ldsrc = DM; j.nvalid = DM; conv_tile(j, idx % 44, idx / 44, lds); }
}

__device__ void phase_rows(const Params& p, int mode, int l, int nrows, bool store) {
    const int tid_ = otid(); const int lane = tid_ & 63, gw = blockIdx.x * 8 + (tid_ >> 6), nw = gridDim.x * 8;
    const float* MOD = (const float*)(p.ws + O_MOD);
    bf16_t* H = (bf16_t*)(p.ws + O_H);
    const float* lg = mode == 1 ? p.in[26] + l * DM : p.in[28] + l * DM;
    const float* lb = mode == 1 ? p.in[27] + l * DM : p.in[29] + l * DM;
    const int ml = mode == 2 ? l + 1 : l;
    const bool wh = !(mode == 2 && l == NL - 1);
    const int sci = mode == 1 ? 4 : 1, shi = mode == 1 ? 3 : 0;
#define ROWS_SRC(r) (mode == 0 ? ((r) < NLAT ? p.in[0] + (size_t)(r) * DM : p.in[2] + (size_t)((r) - NLAT) * DM) : (const float*)xrow(p, (r)))
    f32x4 nv[4];
    if (gw < nrows) { const float* s0 = ROWS_SRC(gw);
#pragma unroll
        for (int i = 0; i < 4; ++i) nv[i] = *(const f32x4*)(s0 + i * 256 + lane * 4); }
    for (int row = gw; row < nrows; row += nw) {
        float* xp = xrow(p, row);
        f32x4 v[4];
#pragma unroll
        for (int i = 0; i < 4; ++i) v[i] = nv[i];
        if (row + nw < nrows) { const float* s1 = ROWS_SRC(row + nw);
#pragma unroll
            for (int i = 0; i < 4; ++i) nv[i] = *(const f32x4*)(s1 + i * 256 + lane * 4); }
        if (mode == 0) {
#pragma unroll
            for (int i = 0; i < 4; ++i) { if (store) *(f32x4*)(xp + i * 256 + lane * 4) = v[i]; }
        } else {
            float s = 0.f;
#pragma unroll
            for (int i = 0; i < 4; ++i) s += v[i][0] + v[i][1] + v[i][2] + v[i][3];
#pragma unroll
            for (int o = 1; o < 64; o <<= 1) s += __shfl_xor(s, o);
            const float mu = s * (1.f / 1024.f);
            float q = 0.f;
#pragma unroll
            for (int i = 0; i < 4; ++i) { v[i] -= mu; q += v[i][0] * v[i][0] + v[i][1] * v[i][1] + v[i][2] * v[i][2] + v[i][3] * v[i][3]; }
#pragma unroll
            for (int o = 1; o < 64; o <<= 1) q += __shfl_xor(q, o);
            const float rs = rsqrtf(q * (1.f / 1024.f) + 1e-5f);
#pragma unroll
            for (int i = 0; i < 4; ++i) { const f32x4 g4 = *(const f32x4*)(lg + i * 256 + lane * 4), b4 = *(const f32x4*)(lb + i * 256 + lane * 4); v[i] = v[i] * rs * g4 + b4; if (store) *(f32x4*)(xp + i * 256 + lane * 4) = v[i]; }
        }
        if (wh && store) {
            const float* mb = MOD + ((size_t)ml * 5 + mod_batch(row)) * 6144;
#pragma unroll
            for (int i = 0; i < 4; ++i) {
                const f32x4 sc = *(const f32x4*)(mb + sci * 1024 + i * 256 + lane * 4), sh = *(const f32x4*)(mb + shi * 1024 + i * 256 + lane * 4);
                const f32x4 h = v[i] * (sc + 1.f) + sh;
                u32x2 o; o[0] = cvt_pk_bf16(h[0], h[1]); o[1] = cvt_pk_bf16(h[2], h[3]);
                *(u32x2*)(H + (size_t)row * DM + i * 256 + lane * 4) = o;
            }
        }
    }
}

constexpr int ALD = 392;
__device__ void phase_prep(const Params& p, int l, unsigned char* smem) {
    const int tid = otid(), wid = tid >> 6, lane = tid & 63, fr = lane & 15, fq = lane >> 4;
    const bf16_t* P = (const bf16_t*)(p.ws + O_P);
    bf16_t* RS = (bf16_t*)(p.ws + O_H); bf16_t* KS = RS + (size_t)NTOK * 512;
    bf16_t* VS = (bf16_t*)(p.ws + O_VS); bf16_t* KK = (bf16_t*)(p.ws + O_KK);
    bf16_t* OMD = (bf16_t*)(p.ws + O_OMD); bf16_t* AA = (bf16_t*)(p.ws + O_AA); bf16_t* GG = (bf16_t*)(p.ws + O_GG);
    const bf16_t* W2T = (const bf16_t*)(p.ws + O_W2T) + (size_t)l * 2 * 512 * 64;
    const bf16_t* A2T = (const bf16_t*)(p.ws + O_A2T) + (size_t)l * 2 * 512 * 64;
    const bf16_t* G2T = (const bf16_t*)(p.ws + O_G2T) + (size_t)l * 512 * 128;
    const float* mup = p.in[8] + l * 1920; const float* mun = p.in[9] + l * 1920;
    const float* kkw = p.in[15] + l * 512;
    const float* w0 = p.in[10] + l * 1024; const float* a0 = p.in[12] + l * 1024;
    bf16_t* At = (bf16_t*)smem;
    constexpr int PT = 68;
    for (int tile = blockIdx.x; tile < NTOK / PT; tile += gridDim.x) {
        {
            const int t0 = wid * 9, rbase = tile * PT + t0;
#pragma unroll 1
            for (int ch = 0; ch < 4; ++ch) {
                if (ch == 3 && lane >= 48) break;
                const int c = ch * 512 + lane * 8;
                u32x4 rw[11];
#pragma unroll
                for (int i = 0; i < 11; ++i) {
                    const int rr = min(max(rbase - 1 + i, 0), NTOK - 1);
                    rw[i] = *(const u32x4*)(P + (size_t)rr * LDP + OFF_RW + c);
                }
                const f32x4 mp0 = *(const f32x4*)(mup + c), mp1 = *(const f32x4*)(mup + c + 4), mn0 = *(const f32x4*)(mun + c), mn1 = *(const f32x4*)(mun + c + 4);
                f32x4 k0 = {0.f, 0.f, 0.f, 0.f}, k1 = {0.f, 0.f, 0.f, 0.f};
                if (ch == 1) { k0 = *(const f32x4*)(kkw + lane * 8); k1 = *(const f32x4*)(kkw + lane * 8 + 4); }
#pragma unroll
                for (int i = 0; i < 9; ++i) {
                    const int t = t0 + i, row = rbase + i;
                    if (t >= PT) break;
                    const bool first = row < NLAT ? ((row & 4095) == 0) : (((row - NLAT) & 255) == 0);
                    const bool lastt = row < NLAT ? ((row & 4095) == 4095) : (((row - NLAT) & 255) == 255);
                    float cur[8], prv[8], nxt[8], sv[8];
                    unpack8(rw[i + 1], cur); unpack8(rw[i], prv); unpack8(rw[i + 2], nxt);
#pragma unroll
                    for (int e = 0; e < 8; ++e) {
                        const float mp = e < 4 ? mp0[e] : mp1[e - 4], mn = e < 4 ? mn0[e] : mn1[e - 4];
                        const float pv = first ? 0.f : prv[e], nv = lastt ? 0.f : nxt[e];
                        sv[e] = cur[e] + mp * (pv - cur[e]) + mn * (nv - cur[e]);
                    }
                    if (ch == 0) *(u32x4*)(RS + (size_t)row * 512 + lane * 8) = pack8(sv);
                    else if (ch == 1) {
                        *(u32x4*)(KS + (size_t)row * 512 + lane * 8) = pack8(sv);
                        float kv[8], ss = 0.f;
#pragma unroll
                        for (int e = 0; e < 8; ++e) { kv[e] = sv[e] * (e < 4 ? k0[e] : k1[e - 4]); ss += kv[e] * kv[e]; }
                        ss += __shfl_xor(ss, 1); ss += __shfl_xor(ss, 2); ss += __shfl_xor(ss, 4);
                        const float rn = rsqrtf(ss + 1e-12f);
#pragma unroll
                        for (int e = 0; e < 8; ++e) kv[e] *= rn;
                        *(u32x4*)(KK + (size_t)row * 512 + lane * 8) = pack8(kv);
                    } else if (ch == 2) *(u32x4*)(VS + (size_t)row * 512 + lane * 8) = pack8(sv);
                    else {
                        const int cc = lane * 8;
                        if (cc < 128) {
#pragma unroll
                            for (int e = 0; e < 8; ++e) sv[e] = 1.f - 2.f / (__expf(2.f * sv[e]) + 1.f);
                        } else if (cc >= 256) {
#pragma unroll
                            for (int e = 0; e < 8; ++e) sv[e] = sigmoidf_(sv[e]);
                        }
                        *(u32x4*)(At + t * ALD + cc) = pack8(sv);
                    }
                }
            }
        }
        __syncthreads();
#pragma unroll 1
        for (int mat = 0; mat < 5; ++mat) {
            const int dir = mat & 1;
            const bf16_t* Wt = mat < 2 ? W2T + (size_t)dir * 512 * 64 : mat < 4 ? A2T + (size_t)dir * 512 * 64 : G2T;
            const int Kd = mat < 4 ? 64 : 128;
            const int koff = mat < 2 ? dir * 64 : mat < 4 ? 128 + dir * 64 : 256;
#pragma unroll 1
            for (int nt_ = 0; nt_ < 4; ++nt_) {
                const int cb = wid * 64 + nt_ * 16;
                bf16x8 wf[4];
                const bf16_t* wp = Wt + (size_t)(cb + fr) * Kd + fq * 8;
                wf[0] = *(const bf16x8*)wp; wf[1] = *(const bf16x8*)(wp + 32);
                if (mat == 4) { wf[2] = *(const bf16x8*)(wp + 64); wf[3] = *(const bf16x8*)(wp + 96); } else { wf[2] = wf[0]; wf[3] = wf[1]; }
                const int c4 = cb + fq * 4;
                f32x4 bias = {0.f, 0.f, 0.f, 0.f};
                if (mat < 2) bias = *(const f32x4*)(w0 + dir * 512 + c4); else if (mat < 4) bias = *(const f32x4*)(a0 + dir * 512 + c4);
#pragma unroll
                for (int tt = 0; tt < 5; ++tt) {
                    const bf16_t* ap = At + (tt * 16 + fr) * ALD + koff + fq * 8;
                    f32x4 acc = {0.f, 0.f, 0.f, 0.f};
                    acc = __builtin_amdgcn_mfma_f32_16x16x32_bf16(wf[0], *(const bf16x8*)ap, acc, 0, 0, 0);
                    acc = __builtin_amdgcn_mfma_f32_16x16x32_bf16(wf[1], *(const bf16x8*)(ap + 32), acc, 0, 0, 0);
                    if (mat == 4) {
                        acc = __builtin_amdgcn_mfma_f32_16x16x32_bf16(wf[2], *(const bf16x8*)(ap + 64), acc, 0, 0, 0);
                        acc = __builtin_amdgcn_mfma_f32_16x16x32_bf16(wf[3], *(const bf16x8*)(ap + 96), acc, 0, 0, 0);
                    }
                    const int row = tile * PT + tt * 16 + fr;
                    float o[4];
                    if (mat < 2) {
#pragma unroll
                        for (int e = 0; e < 4; ++e) {
                            const float x = -(bias[e] + acc[e]);
                            const float ee = 0.6065306597126334f * __builtin_amdgcn_rcpf(1.f + __expf(x));
                            o[e] = 1.f - __expf(-ee);
                        }
                    } else if (mat < 4) {
#pragma unroll
                        for (int e = 0; e < 4; ++e) o[e] = sigmoidf_(bias[e] + acc[e]);
                    } else {
#pragma unroll
                        for (int e = 0; e < 4; ++e) o[e] = acc[e];
                    }
                    u32x2 ov; ov[0] = cvt_pk_bf16(o[0], o[1]); ov[1] = cvt_pk_bf16(o[2], o[3]);
                    bf16_t* dst = mat < 2 ? OMD + (size_t)dir * NTOK * 512 : mat < 4 ? AA + (size_t)dir * NTOK * 512 : GG;
                    if (tt * 16 + fr < PT) *(u32x2*)(dst + (size_t)row * 512 + c4) = ov;
                }
            }
        }
        __syncthreads();
    }
}

constexpr int SC_KT = 0, SC_RT = 2304, SC_KBT = 4608, SC_BBT = 6656, SC_VT = 8704, SC_TM = 10752, SC_BM = 11264, SC_E = 11776, SC_F = 12288, SC_WC = 12800, SC_SLOT = 13056;
constexpr int SC_SCR = 8 * SC_SLOT, SC_SCRSZ = 6144;
static_assert(SC_SCR + 4 * SC_SCRSZ <= 131072, "scan LDS");
union BF8 { u32x4 u; bf16x8 v; };
__device__ __forceinline__ bf16x8 pack4z(const f32x4 d) { BF8 r; r.u[0] = cvt_pk_bf16(d[0], d[1]); r.u[1] = cvt_pk_bf16(d[2], d[3]); r.u[2] = 0u; r.u[3] = 0u; return r.v; }
__device__ __forceinline__ bf16x8 ldx4z(const bf16_t* q) { const bf16x4 t = *(const bf16x4*)q; const bf16x4 z = {0, 0, 0, 0}; return __builtin_shufflevector(t, z, 0, 1, 2, 3, 4, 5, 6, 7); }
__device__ __forceinline__ void stD16(bf16_t* M, const f32x4 d, int fr, int fq) {
#pragma unroll
    for (int jj = 0; jj < 4; ++jj) M[(fq * 4 + jj) * 16 + fr] = f2bf(d[jj]);
    asm volatile("" ::: "memory");
}
struct ConsOps { bf16x4 kt[4], rt[4], kb[4], bb[4], bm, e, tm, f, vy, vy2; f32x4 wc[4]; };
__device__ __forceinline__ bf16x8 z8(const bf16x4 t) { const bf16x4 z = {0, 0, 0, 0}; return __builtin_shufflevector(t, z, 0, 1, 2, 3, 4, 5, 6, 7); }
#define MFMA16(X, Y, C) __builtin_amdgcn_mfma_f32_16x16x32_bf16((X), (Y), (C), 0, 0, 0)

__device__ void scan_chain(const Params& p, int l, int chain, unsigned char* smem) {
    const int tid = otid(), wid = __builtin_amdgcn_readfirstlane(tid >> 6), lane = tid & 63, fr = lane & 15, fq = lane >> 4;
    const int dir = chain >> 5, b = (chain >> 3) & 3, h = chain & 7;
    const bf16_t* RS = (const bf16_t*)(p.ws + O_H); const bf16_t* KS = RS + (size_t)NTOK * 512;
    const bf16_t* VS = (const bf16_t*)(p.ws + O_VS); const bf16_t* KK = (const bf16_t*)(p.ws + O_KK);
    const bf16_t* OMD = (const bf16_t*)(p.ws + O_OMD) + (size_t)dir * NTOK * 512; const bf16_t* AA = (const bf16_t*)(p.ws + O_AA) + (size_t)dir * NTOK * 512;
    bf16_t* P = (bf16_t*)(p.ws + O_P);
    const int rstep = dir ? -1 : 1;
    constexpr int NGRP = (CTXL + SEQ) / 64;
    f32x4 st[2][4];
#pragma unroll
    for (int vt = 0; vt < 2; ++vt)
#pragma unroll
        for (int kt = 0; kt < 4; ++kt) st[vt][kt] = (f32x4){0.f, 0.f, 0.f, 0.f};
    const int li = lane >> 2, c16 = (lane & 3) * 16;
    float ka16[16];
#pragma unroll
    for (int e = 0; e < 16; ++e) ka16[e] = p.in[16][l * 512 + h * 64 + c16 + e];
    u32x4 raw[12];
#define SCAN_ROW0(cc) (((cc) * 16) < 256 ? NLAT + b * 256 + (dir ? 255 - (cc) * 16 : (cc) * 16) : b * 4096 + (dir ? 4095 - ((cc) * 16 - 256) : ((cc) * 16 - 256)))
#define SCAN_LOADRAW(cc) do { const size_t o_ = (size_t)(SCAN_ROW0(cc) + li * rstep) * 512 + h * 64 + c16; \
        raw[0] = *(const u32x4*)(RS + o_); raw[1] = *(const u32x4*)(RS + o_ + 8); raw[2] = *(const u32x4*)(KS + o_); raw[3] = *(const u32x4*)(KS + o_ + 8); \
        raw[4] = *(const u32x4*)(VS + o_); raw[5] = *(const u32x4*)(VS + o_ + 8); raw[6] = *(const u32x4*)(KK + o_); raw[7] = *(const u32x4*)(KK + o_ + 8); \
        raw[8] = *(const u32x4*)(OMD + o_); raw[9] = *(const u32x4*)(OMD + o_ + 8); raw[10] = *(const u32x4*)(AA + o_); raw[11] = *(const u32x4*)(AA + o_ + 8); } while (0)
#pragma unroll
    for (int e = 0; e < 12; ++e) raw[e] = (u32x4){0u, 0u, 0u, 0u};
    const bool is_prod = (wid & 2) == 0;
    const int pj = (wid & 1) + ((wid >> 2) << 1);
    const int cw = wid & 1;
    if (is_prod) SCAN_LOADRAW(pj);
    if (is_prod) {
#pragma unroll 1
      for (int g = -1; g < NGRP; ++g) {
        {
            const int j = pj, gg = g + 1;
            if (gg < NGRP) for (int rp2 = 0; rp2 < p.rep[14]; ++rp2) {
                const int s0 = (gg * 4 + j) * 16;
                const int row0 = s0 < 256 ? NLAT + b * 256 + (dir ? 255 - s0 : s0) : b * 4096 + (dir ? 4095 - (s0 - 256) : (s0 - 256));
                unsigned char* slot = smem + ((gg & 1) * 4 + j) * SC_SLOT;
                unsigned char* scr = smem + SC_SCR + j * SC_SCRSZ;
                bf16_t* Kt = (bf16_t*)(slot + SC_KT); bf16_t* Rt = (bf16_t*)(slot + SC_RT);
                bf16_t* Kh = (bf16_t*)(scr); bf16_t* Bh = (bf16_t*)(scr + 2304);
                bf16_t* P1 = (bf16_t*)(scr + 4608); bf16_t* P2 = (bf16_t*)(scr + 5120); bf16_t* P4 = (bf16_t*)(scr + 5632);
                float* Wbuf = (float*)(slot + SC_KBT);
                const u32x4 vraw0 = raw[4], vraw1 = raw[5];
                const u32x4 cr0 = raw[0], cr1 = raw[1], ck0 = raw[2], ck1 = raw[3], cq0 = raw[6], cq1 = raw[7], ca0 = raw[10], ca1 = raw[11];
                f32x4 wown[4];
                {
                    float om[2][8];
                    unpack8(raw[8], om[0]); unpack8(raw[9], om[1]);
#pragma unroll
                    for (int hh = 0; hh < 2; ++hh) {
                        wown[hh * 2] = (f32x4){1.f - om[hh][0], 1.f - om[hh][1], 1.f - om[hh][2], 1.f - om[hh][3]};
                        wown[hh * 2 + 1] = (f32x4){1.f - om[hh][4], 1.f - om[hh][5], 1.f - om[hh][6], 1.f - om[hh][7]};
                        *(f32x4*)(Wbuf + li * 64 + c16 + hh * 8) = wown[hh * 2];
                        *(f32x4*)(Wbuf + li * 64 + c16 + hh * 8 + 4) = wown[hh * 2 + 1];
                    }
                }
                asm volatile("" ::: "memory");
                {
                    float wcol[16];
#pragma unroll
                    for (int i = 0; i < 16; ++i) wcol[i] = Wbuf[i * 64 + lane];
                    float Wc = 1.f;
#pragma unroll
                    for (int i = 0; i < 16; ++i) { Wc *= wcol[i]; Wbuf[i * 64 + lane] = Wc; }
                }
                asm volatile("" ::: "memory");
                f32x4 Wv[4], Wm[4], iWv[4];
#pragma unroll
                for (int q4 = 0; q4 < 4; ++q4) {
                    Wv[q4] = *(const f32x4*)(Wbuf + li * 64 + c16 + q4 * 4);
#pragma unroll
                    for (int e = 0; e < 4; ++e) {
                        iWv[q4][e] = __builtin_amdgcn_rcpf(Wv[q4][e]);
                        Wm[q4][e] = li > 0 ? Wv[q4][e] * __builtin_amdgcn_rcpf(wown[q4][e]) : 1.f;
                    }
                }
                asm volatile("" ::: "memory");
                {
                    bf16_t* KbT = (bf16_t*)(slot + SC_KBT); bf16_t* BbT = (bf16_t*)(slot + SC_BBT); bf16_t* VTs = (bf16_t*)(slot + SC_VT);
#pragma unroll
                    for (int hh = 0; hh < 2; ++hh) {
                        float okt[8], ort[8], okh[8], obh[8], rr[8], kx[8], kq[8], av[8];
                        unpack8(hh ? cr1 : cr0, rr); unpack8(hh ? ck1 : ck0, kx); unpack8(hh ? cq1 : cq0, kq); unpack8(hh ? ca1 : ca0, av);
#pragma unroll
                        for (int e = 0; e < 8; ++e) {
                            const int ce = hh * 8 + e, q4 = ce >> 2, qi = ce & 3;
                            const float kd = kx[e] * (1.f + (av[e] - 1.f) * ka16[ce]), bb = kq[e] * av[e];
                            okt[e] = kq[e] * Wm[q4][qi]; ort[e] = rr[e] * Wv[q4][qi];
                            okh[e] = kd * iWv[q4][qi]; obh[e] = bb * iWv[q4][qi];
                        }
                        *(u32x4*)(Kt + li * 72 + c16 + hh * 8) = pack8(okt); *(u32x4*)(Rt + li * 72 + c16 + hh * 8) = pack8(ort);
                        *(u32x4*)(Kh + li * 72 + c16 + hh * 8) = pack8(okh); *(u32x4*)(Bh + li * 72 + c16 + hh * 8) = pack8(obh);
                    }
                    *(u32x4*)(VTs + li * 64 + c16) = vraw0; *(u32x4*)(VTs + li * 64 + c16 + 8) = vraw1;
                    asm volatile("" ::: "memory");
                    const float WC = Wbuf[15 * 64 + lane];
                    float kcol[16], bcol[16]; unsigned vcol[16];
#pragma unroll
                    for (int i = 0; i < 16; ++i) { kcol[i] = bf2f(Kh[i * 72 + lane]) * WC; bcol[i] = bf2f(Bh[i * 72 + lane]) * WC; vcol[i] = VTs[i * 64 + lane]; }
                    asm volatile("" ::: "memory");
                    u32x4 t0, t1;
#pragma unroll
                    for (int e = 0; e < 4; ++e) { t0[e] = cvt_pk_bf16(kcol[2 * e], kcol[2 * e + 1]); t1[e] = cvt_pk_bf16(kcol[8 + 2 * e], kcol[8 + 2 * e + 1]); }
                    *(u32x4*)(KbT + lane * 16) = t0; *(u32x4*)(KbT + lane * 16 + 8) = t1;
#pragma unroll
                    for (int e = 0; e < 4; ++e) { t0[e] = cvt_pk_bf16(bcol[2 * e], bcol[2 * e + 1]); t1[e] = cvt_pk_bf16(bcol[8 + 2 * e], bcol[8 + 2 * e + 1]); }
                    *(u32x4*)(BbT + lane * 16) = t0; *(u32x4*)(BbT + lane * 16 + 8) = t1;
#pragma unroll
                    for (int e = 0; e < 4; ++e) { t0[e] = vcol[2 * e] | (vcol[2 * e + 1] << 16); t1[e] = vcol[8 + 2 * e] | (vcol[8 + 2 * e + 1] << 16); }
                    *(u32x4*)(VTs + lane * 16) = t0; *(u32x4*)(VTs + lane * 16 + 8) = t1;
                    ((float*)(slot + SC_WC))[lane] = WC;
                }
                asm volatile("" ::: "memory");
                if (gg + 1 < NGRP && rp2 == p.rep[14] - 1) SCAN_LOADRAW((gg + 1) * 4 + j);
                const bf16x8 ktx0 = *(const bf16x8*)(Kt + fr * 72 + fq * 8), ktx1 = *(const bf16x8*)(Kt + fr * 72 + 32 + fq * 8);
                const bf16x8 rtx0 = *(const bf16x8*)(Rt + fr * 72 + fq * 8), rtx1 = *(const bf16x8*)(Rt + fr * 72 + 32 + fq * 8);
                const bf16x8 khy0 = *(const bf16x8*)(Kh + fr * 72 + fq * 8), khy1 = *(const bf16x8*)(Kh + fr * 72 + 32 + fq * 8);
                const bf16x8 bhy0 = *(const bf16x8*)(Bh + fr * 72 + fq * 8), bhy1 = *(const bf16x8*)(Bh + fr * 72 + 32 + fq * 8);
                const f32x4 z4 = {0.f, 0.f, 0.f, 0.f};
                f32x4 A = MFMA16(ktx0, bhy0, z4); A = MFMA16(ktx1, bhy1, A);
                f32x4 Bm = MFMA16(ktx0, khy0, z4); Bm = MFMA16(ktx1, khy1, Bm);
                f32x4 E = MFMA16(rtx0, khy0, z4); E = MFMA16(rtx1, khy1, E);
                f32x4 F = MFMA16(rtx0, bhy0, z4); F = MFMA16(rtx1, bhy1, F);
                f32x4 I4, N;
#pragma unroll
                for (int jj = 0; jj < 4; ++jj) {
                    const int i = fq * 4 + jj;
                    I4[jj] = (i == fr) ? 1.f : 0.f;
                    N[jj] = (fr < i) ? -A[jj] : 0.f;
                    Bm[jj] = (fr < i) ? Bm[jj] : 0.f;
                    E[jj] = (fr <= i) ? E[jj] : 0.f;
                    F[jj] = (fr <= i) ? F[jj] : 0.f;
                }
                stD16(P1, I4 + N, fr, fq);
                f32x4 N2 = MFMA16(ldx4z(P1 + fr * 16 + fq * 4), pack4z(N), -N);
                stD16(P2, I4 + N2, fr, fq);
                f32x4 N4 = MFMA16(ldx4z(P2 + fr * 16 + fq * 4), pack4z(N2), -N2);
                stD16(P4, I4 + N4, fr, fq);
                f32x4 N8 = MFMA16(ldx4z(P4 + fr * 16 + fq * 4), pack4z(N4), -N4);
                f32x4 Tm = I4 + N8;
                Tm = MFMA16(ldx4z(P4 + fr * 16 + fq * 4), pack4z(Tm), z4);
                Tm = MFMA16(ldx4z(P2 + fr * 16 + fq * 4), pack4z(Tm), z4);
                Tm = MFMA16(ldx4z(P1 + fr * 16 + fq * 4), pack4z(Tm), z4);
                stD16((bf16_t*)(slot + SC_TM), Tm, fr, fq); stD16((bf16_t*)(slot + SC_BM), Bm, fr, fq);
                stD16((bf16_t*)(slot + SC_E), E, fr, fq); stD16((bf16_t*)(slot + SC_F), F, fr, fq);
            }
        }
        asm volatile("s_waitcnt lgkmcnt(0)" ::: "memory");
        __builtin_amdgcn_s_barrier();
        asm volatile("" ::: "memory");
      }
    } else {
#pragma unroll 1
      for (int g = -1; g < NGRP; ++g) {
        if (g >= 0 && wid < 4) {
#define CONS_LOAD(O, jj_) do { const unsigned char* sl_ = smem + ((g & 1) * 4 + (jj_)) * SC_SLOT; \
                _Pragma("unroll") for (int kt = 0; kt < 4; ++kt) { \
                    O.kt[kt] = *(const bf16x4*)((const bf16_t*)(sl_ + SC_KT) + fr * 72 + kt * 16 + fq * 4); O.rt[kt] = *(const bf16x4*)((const bf16_t*)(sl_ + SC_RT) + fr * 72 + kt * 16 + fq * 4); \
                    O.kb[kt] = *(const bf16x4*)((const bf16_t*)(sl_ + SC_KBT) + (kt * 16 + fr) * 16 + fq * 4); O.bb[kt] = *(const bf16x4*)((const bf16_t*)(sl_ + SC_BBT) + (kt * 16 + fr) * 16 + fq * 4); \
                    O.wc[kt] = *(const f32x4*)((const float*)(sl_ + SC_WC) + kt * 16 + fq * 4); } \
                O.bm = *(const bf16x4*)((const bf16_t*)(sl_ + SC_BM) + fr * 16 + fq * 4); O.e = *(const bf16x4*)((const bf16_t*)(sl_ + SC_E) + fr * 16 + fq * 4); \
                O.tm = *(const bf16x4*)((const bf16_t*)(sl_ + SC_TM) + fr * 16 + fq * 4); O.f = *(const bf16x4*)((const bf16_t*)(sl_ + SC_F) + fr * 16 + fq * 4); \
                O.vy = *(const bf16x4*)((const bf16_t*)(sl_ + SC_VT) + (cw * 32 + fr) * 16 + fq * 4); O.vy2 = *(const bf16x4*)((const bf16_t*)(sl_ + SC_VT) + (cw * 32 + 16 + fr) * 16 + fq * 4); } while (0)
#pragma unroll
            for (int j = 0; j < 4; ++j) {
                ConsOps cur;
                CONS_LOAD(cur, j);
                const int s0 = (g * 4 + j) * 16;
                const int row0 = s0 < 256 ? NLAT + b * 256 + (dir ? 255 - s0 : s0) : b * 4096 + (dir ? 4095 - (s0 - 256) : (s0 - 256));
                const f32x4 z4 = {0.f, 0.f, 0.f, 0.f};
#pragma unroll
                for (int vt = 0; vt < 2; ++vt) {
                    const bf16x8 VY = z8(vt ? cur.vy2 : cur.vy);
                    bf16x8 sb[4]; f32x4 tk[4];
#pragma unroll
                    for (int kt = 0; kt < 4; ++kt) sb[kt] = pack4z(st[vt][kt]);
                    f32x4 X1 = z4, Yo = z4;
#pragma unroll
                    for (int kt = 0; kt < 4; ++kt) X1 = MFMA16(z8(cur.kt[kt]), sb[kt], X1);
                    X1 = MFMA16(z8(cur.bm), VY, X1);
#pragma unroll
                    for (int kt = 0; kt < 4; ++kt) tk[kt] = MFMA16(z8(cur.kb[kt]), VY, st[vt][kt] * cur.wc[kt]);
#pragma unroll
                    for (int kt = 0; kt < 4; ++kt) Yo = MFMA16(z8(cur.rt[kt]), sb[kt], Yo);
                    Yo = MFMA16(z8(cur.e), VY, Yo);
                    const f32x4 U = MFMA16(z8(cur.tm), pack4z(X1), z4);
                    const bf16x8 nUb = pack4z(-U);
#pragma unroll
                    for (int kt = 0; kt < 4; ++kt) st[vt][kt] = MFMA16(z8(cur.bb[kt]), nUb, tk[kt]);
                    Yo = MFMA16(z8(cur.f), nUb, Yo);
#pragma unroll
                    for (int jj = 0; jj < 4; ++jj) {
                        const int row = row0 + (fq * 4 + jj) * rstep;
                        P[(size_t)row * LDP + OFF_RW + dir * 512 + h * 64 + (cw * 2 + vt) * 16 + fr] = f2bf(Yo[jj]);
                    }
                }
            }
#undef CONS_LOAD
        }
        asm volatile("s_waitcnt lgkmcnt(0)" ::: "memory");
        __builtin_amdgcn_s_barrier();
        asm volatile("" ::: "memory");
      }
    }
}

__device__ void phase_readout(const Params& p, int l, int nrows) {
    const int tid_ = otid(); const int lane = tid_ & 63, gw = blockIdx.x * 8 + (tid_ >> 6), nw = gridDim.x * 8;
    const bf16_t* RS = (const bf16_t*)(p.ws + O_H); const bf16_t* KS = RS + (size_t)NTOK * 512;
    const bf16_t* VS = (const bf16_t*)(p.ws + O_VS);
    const bf16_t* AA = (const bf16_t*)(p.ws + O_AA); const bf16_t* GG = (const bf16_t*)(p.ws + O_GG);
    bf16_t* P = (bf16_t*)(p.ws + O_P);
    const int c = lane * 8;
    float gng[8], gnb[8], rk[8], ka[8];
#pragma unroll
    for (int e = 0; e < 8; ++e) { gng[e] = p.in[18][l * 512 + c + e]; gnb[e] = p.in[19][l * 512 + c + e]; rk[e] = p.in[17][l * 512 + c + e]; ka[e] = p.in[16][l * 512 + c + e]; }
#define RO_LOAD(r, D) do { const bf16_t* pr_ = P + (size_t)(r) * LDP + OFF_RW; const size_t o_ = (size_t)(r) * 512 + c; \
        D[0] = *(const u32x4*)(pr_ + c); D[1] = *(const u32x4*)(pr_ + 512 + c); D[2] = *(const u32x4*)(RS + o_); D[3] = *(const u32x4*)(KS + o_); D[4] = *(const u32x4*)(VS + o_); \
        D[5] = *(const u32x4*)(AA + o_); D[6] = *(const u32x4*)(AA + (size_t)NTOK * 512 + o_); D[7] = *(const u32x4*)(GG + o_); } while (0)
    u32x4 nx[8];
    if (gw < nrows) RO_LOAD(gw, nx);
    for (int row = gw; row < nrows; row += nw) {
        bf16_t* pr = P + (size_t)row * LDP + OFF_RW;
        u32x4 cu[8];
#pragma unroll
        for (int i = 0; i < 8; ++i) cu[i] = nx[i];
        if (row + nw < nrows) RO_LOAD(row + nw, nx);
        float y0[8], y1[8], y[8];
        unpack8(cu[0], y0); unpack8(cu[1], y1);
        float s = 0.f;
#pragma unroll
        for (int e = 0; e < 8; ++e) { y[e] = y0[e] + y1[e]; s += y[e]; }
        s += __shfl_xor(s, 1); s += __shfl_xor(s, 2); s += __shfl_xor(s, 4);
        const float mu = s * (1.f / 64.f);
        float qv = 0.f;
#pragma unroll
        for (int e = 0; e < 8; ++e) { y[e] -= mu; qv += y[e] * y[e]; }
        qv += __shfl_xor(qv, 1); qv += __shfl_xor(qv, 2); qv += __shfl_xor(qv, 4);
        const float rs = rsqrtf(qv * (1.f / 64.f) + 64e-5f);
        float r[8], k[8], v[8], a0[8], a1[8], g[8];
        unpack8(cu[2], r); unpack8(cu[3], k); unpack8(cu[4], v);
        unpack8(cu[5], a0); unpack8(cu[6], a1); unpack8(cu[7], g);
        float bon = 0.f;
#pragma unroll
        for (int e = 0; e < 8; ++e) { const float kd = k[e] * (2.f + (a0[e] + a1[e] - 2.f) * ka[e]); bon += r[e] * kd * rk[e]; }
        bon += __shfl_xor(bon, 1); bon += __shfl_xor(bon, 2); bon += __shfl_xor(bon, 4);
        float ov[8];
#pragma unroll
        for (int e = 0; e < 8; ++e) ov[e] = (y[e] * rs * gng[e] + gnb[e] + bon * v[e]) * g[e];
        *(u32x4*)(pr + 1024 + c) = pack8(ov);
    }
}

template <bool CTX>
__device__ __forceinline__ void na_item_t(const Params& p, int l, int item, bool store, const float* rpbL) {
    const int tid = otid(); const int wid = tid >> 6, lane = tid & 63, fr = lane & 15, fq = lane >> 4;
    bf16_t* P = (bf16_t*)(p.ws + O_P);
    const bf16_t* VT = (const bf16_t*)(p.ws + O_VT);
    const int h = wid;
    int b, r = 0, j = 0, tq0, row0 = 0, ks0 = 0;
    if (!CTX) { b = item >> 8; r = (item >> 2) & 63; j = item & 3; tq0 = b * 4096 + r * 64 + j * 16; row0 = min(max(r - 4, 0), 56); ks0 = min(max(16 * j - 8, 0), 32); }
    else { b = item >> 4; tq0 = NLAT + b * 256 + (item & 15) * 16; }
    const bf16_t* qp = P + (size_t)(tq0 + fr) * LDP + OFF_Q + h * 64 + fq * 8;
    const bf16x8 bq0 = *(const bf16x8*)qp, bq1 = *(const bf16x8*)(qp + 32);
    f32x4 sc[32];
    const float* rpb = rpbL + h * 465;
    const int c = j * 16 + fr, kc0 = min(max(c - 8, 0), 48);
    constexpr int T0 = CTX ? 16 : 0;
    const f32x4 z4 = {0.f, 0.f, 0.f, 0.f};
    const int mperm = (fr >> 2) * 8 + (fr & 3);
#pragma unroll
    for (int tg = T0 / 8; tg < 4; ++tg) {
        bf16x8 kf[8][2];
#pragma unroll
        for (int t8 = 0; t8 < 8; ++t8) {
            const int t = tg * 8 + t8, tp = t >> 1, sfx = t & 1;
            const int tok = (tp < 8 ? b * 4096 + (row0 + tp) * 64 + ks0 : NLAT + b * 256 + (tp - 8) * 32) + mperm + sfx * 4;
            const bf16_t* kp = P + (size_t)tok * LDP + OFF_K + h * 64 + fq * 8;
            kf[t8][0] = *(const bf16x8*)kp; kf[t8][1] = *(const bf16x8*)(kp + 32);
        }
#pragma unroll
        for (int t8 = 0; t8 < 8; ++t8) {
            const int t = tg * 8 + t8, tp = t >> 1, sfx = t & 1;
            f32x4 a = MFMA16(kf[t8][0], bq0, z4); a = MFMA16(kf[t8][1], bq1, a);
            if (tp < 8) {
                const float* rp = rpb + (row0 + tp - r + 7) * 31;
#pragma unroll
                for (int jj = 0; jj < 4; ++jj) {
                    const int kc = ks0 + fq * 8 + sfx * 4 + jj;
                    const bool valid = kc >= kc0 && kc < kc0 + 16;
                    const float bias = rp[min(max(kc - c + 15, 0), 30)];
                    a[jj] = valid ? a[jj] * 0.125f + bias : -1e30f;
                }
            } else a = a * 0.125f;
            sc[t] = a;
        }
    }
    float mx = -1e30f;
#pragma unroll
    for (int t = T0; t < 32; ++t)
#pragma unroll
        for (int jj = 0; jj < 4; ++jj) mx = fmaxf(mx, sc[t][jj]);
    mx = fmaxf(mx, __shfl_xor(mx, 16)); mx = fmaxf(mx, __shfl_xor(mx, 32));
    float sum = 0.f;
#pragma unroll
    for (int t = T0; t < 32; ++t)
#pragma unroll
        for (int jj = 0; jj < 4; ++jj) { const float e = __expf(sc[t][jj] - mx); sc[t][jj] = e; sum += e; }
    sum += __shfl_xor(sum, 16); sum += __shfl_xor(sum, 32);
    f32x4 o[4];
#pragma unroll
    for (int dt = 0; dt < 4; ++dt) o[dt] = z4;
#pragma unroll
    for (int tpg = T0 / 8; tpg < 4; ++tpg) {
        bf16x8 vf[4][4];
#pragma unroll
        for (int t4 = 0; t4 < 4; ++t4) {
            const int tp = tpg * 4 + t4;
            const int base = (tp < 8 ? b * 4096 + (row0 + tp) * 64 + ks0 : NLAT + b * 256 + (tp - 8) * 32) + fq * 8;
#pragma unroll
            for (int dt = 0; dt < 4; ++dt) vf[t4][dt] = *(const bf16x8*)(VT + (size_t)(h * 64 + dt * 16 + fr) * NTOK + base);
        }
#pragma unroll
        for (int t4 = 0; t4 < 4; ++t4) {
            const int tp = tpg * 4 + t4;
            BF8 ap;
            ap.u[0] = cvt_pk_bf16(sc[2 * tp][0], sc[2 * tp][1]); ap.u[1] = cvt_pk_bf16(sc[2 * tp][2], sc[2 * tp][3]);
            ap.u[2] = cvt_pk_bf16(sc[2 * tp + 1][0], sc[2 * tp + 1][1]); ap.u[3] = cvt_pk_bf16(sc[2 * tp + 1][2], sc[2 * tp + 1][3]);
#pragma unroll
            for (int dt = 0; dt < 4; ++dt) o[dt] = MFMA16(ap.v, vf[t4][dt], o[dt]);
        }
    }
#pragma unroll
    for (int jj = 0; jj < 4; ++jj) {
        const float sj = __shfl(sum, fq * 4 + jj);
        const float inv = 1.f / sj;
        bf16_t* op = P + (size_t)(tq0 + fq * 4 + jj) * LDP + OFF_Q + h * 64 + fr;
#pragma unroll
        for (int dt = 0; dt < 4; ++dt) if (store) op[dt * 16] = f2bf(o[dt][jj] * inv);
    }
}
__device__ void na_item(const Params& p, int l, int item, bool store, const float* rpbL) {
    if (item < 1024) na_item_t<false>(p, l, item, store, rpbL); else na_item_t<true>(p, l, item - 1024, store, rpbL);
}

constexpr int VLD = 136;
__device__ void sgu_item(const Params& p, int l, int chunk, unsigned char* smem, bool store) {
    const int tid = otid(), wid = tid >> 6, lane = tid & 63, fr = lane & 15, fq = lane >> 4;
    bf16_t* P = (bf16_t*)(p.ws + O_P);
    const bf16_t* SGW = (const bf16_t*)(p.ws + O_SGW) + (size_t)l * 8 * 128 * 128;
    float* stats = (float*)smem;
    bf16_t* VnT = (bf16_t*)(smem + 1024);
    const int rowb = chunk * 128;
    for (int i = 0; i < 16; ++i) {
        const int t = wid * 16 + i;
        float f[8]; unpack8(*(const u32x4*)(P + (size_t)(rowb + t) * LDP + OFF_SG + 512 + lane * 8), f);
        float s = 0.f;
#pragma unroll
        for (int e = 0; e < 8; ++e) { f[e] = gelu_tanh(f[e]); s += f[e]; }
#pragma unroll
        for (int o = 1; o < 64; o <<= 1) s += __shfl_xor(s, o);
        const float mu = s * (1.f / 512.f);
        float qv = 0.f;
#pragma unroll
        for (int e = 0; e < 8; ++e) { const float d = f[e] - mu; qv += d * d; }
#pragma unroll
        for (int o = 1; o < 64; o <<= 1) qv += __shfl_xor(qv, o);
        if (lane == 0) { stats[t * 2] = mu; stats[t * 2 + 1] = rsqrtf(qv * (1.f / 512.f) + 1e-5f); }
    }
    __syncthreads();
#pragma unroll 1
    for (int g = 0; g < 8; ++g) {
        {
            const int qq = tid >> 2, cg16 = (tid & 3) * 16;
            const float mu = stats[qq * 2], rs = stats[qq * 2 + 1];
            const bf16_t* vp = P + (size_t)(rowb + qq) * LDP + OFF_SG + 512 + g * 64 + cg16;
#pragma unroll
            for (int hh = 0; hh < 2; ++hh) {
                float f[8]; unpack8(*(const u32x4*)(vp + hh * 8), f);
#pragma unroll
                for (int e = 0; e < 8; ++e) {
                    const int cc = cg16 + hh * 8 + e;
                    const float val = (gelu_tanh(f[e]) - mu) * rs * p.in[20][l * 512 + g * 64 + cc] + p.in[21][l * 512 + g * 64 + cc];
                    VnT[cc * VLD + qq] = f2bf(val);
                }
            }
        }
        __syncthreads();
        {
            const int pp = wid * 16 + fr;
            const bf16_t* wp = SGW + ((size_t)g * 128 + pp) * 128 + fq * 8;
            bf16x8 wf[4];
#pragma unroll
            for (int ks = 0; ks < 4; ++ks) wf[ks] = *(const bf16x8*)(wp + ks * 32);
            const float bs = p.in[23][(l * 8 + g) * 128 + pp];
#pragma unroll
            for (int ct = 0; ct < 4; ++ct) {
                f32x4 acc = {0.f, 0.f, 0.f, 0.f};
#pragma unroll
                for (int ks = 0; ks < 4; ++ks) acc = __builtin_amdgcn_mfma_f32_16x16x32_bf16(*(const bf16x8*)(VnT + (ct * 16 + fr) * VLD + ks * 32 + fq * 8), wf[ks], acc, 0, 0, 0);
                bf16_t* up = P + (size_t)(rowb + pp) * LDP + OFF_SG + g * 64 + ct * 16 + fq * 4;
                float u[4]; unpack4(*(const u32x2*)up, u);
                u32x2 ov;
                ov[0] = cvt_pk_bf16(EN_SGU ? gelu_tanh(u[0]) * (acc[0] + bs) : 0.f, EN_SGU ? gelu_tanh(u[1]) * (acc[1] + bs) : 0.f);
                ov[1] = cvt_pk_bf16(EN_SGU ? gelu_tanh(u[2]) * (acc[2] + bs) : 0.f, EN_SGU ? gelu_tanh(u[3]) * (acc[3] + bs) : 0.f);
                if (store) *(u32x2*)up = ov;
            }
        }
        __syncthreads();
    }
}

#define XB_TMO      128
#define XB_XCNT(j)  (256  + 64 * (j))
#define XB_XSUB(j)  (1280 + 64 * (j))
#define XB_XGEN(j)  (2304 + 64 * (j))
#define XB_TOP      3328
#define XB_TOPGEN   3392
#define XCD_BAR_WORDS 3456
#define XB_SPIN_CAP (1u << 20)
__device__ __forceinline__ unsigned xb_ld(unsigned* p)              { return __hip_atomic_load(p, __ATOMIC_RELAXED, __HIP_MEMORY_SCOPE_AGENT); }
__device__ __forceinline__ unsigned xb_add(unsigned* p, unsigned v) { return __hip_atomic_fetch_add(p, v, __ATOMIC_RELAXED, __HIP_MEMORY_SCOPE_AGENT); }
__device__ __forceinline__ unsigned xb_xcc_id() { return (unsigned)__builtin_amdgcn_s_getreg((3 << 11) | 20) & 0xFu; }
#define XB_SPIN(cond, bar) do { unsigned _sp = 0; while (cond) { __builtin_amdgcn_s_sleep(1); \
    if ((++_sp & 255u) == 0u) { if (xb_ld(&(bar)[XB_TMO])) break; if (_sp > XB_SPIN_CAP) { atomicAdd(&(bar)[XB_TMO], 1u); break; } } } } while (0)
struct XcdBarrier { unsigned* bar; unsigned x; volatile LAS unsigned* st; };
__device__ __forceinline__ XcdBarrier xcd_barrier_post(unsigned* bar, volatile LAS unsigned* st) {
    XcdBarrier b; b.bar = bar; b.x = xb_xcc_id(); b.st = st;
    if (threadIdx.x == 0) (void)xb_add(&bar[XB_XCNT(b.x)], 1u);
    return b;
}
__device__ __forceinline__ void xcd_barrier_complete(unsigned* bar, unsigned x, unsigned& nloc, unsigned& nx) {
    const unsigned G = gridDim.x * gridDim.y * gridDim.z;
    unsigned sum, cnt, mine, sp = 0u;
    for (;;) {
        sum = 0u; cnt = 0u; mine = 0u;
#pragma unroll
        for (unsigned j = 0; j < 16; ++j) { const unsigned c = xb_ld(&bar[XB_XCNT(j)]); sum += c; cnt += (c > 0u) ? 1u : 0u; mine = (j == x) ? c : mine; }
        if (sum == G) break;
        __builtin_amdgcn_s_sleep(1);
        if ((++sp & 255u) == 0u) { if (xb_ld(&bar[XB_TMO])) break; if (sp > XB_SPIN_CAP) { atomicAdd(&bar[XB_TMO], 1u); break; } }
    }
    nloc = mine > 0u ? mine : 1u; nx = cnt > 0u ? cnt : 1u;
}
__device__ __attribute__((noinline)) void xcd_barrier(const XcdBarrier b) {
    asm volatile("s_waitcnt vmcnt(0)" ::: "memory");
    __syncthreads();
    if (threadIdx.x == 0) {
        unsigned* bar = b.bar;
        __builtin_amdgcn_s_waitcnt(0);
        unsigned nloc = b.st[0], nx = b.st[1];
        if (nloc == 0u) { xcd_barrier_complete(bar, b.x, nloc, nx); b.st[0] = nloc; b.st[1] = nx; }
        const unsigned old = xb_add(&bar[XB_XSUB(b.x)], 1u);
        const unsigned gen = old / nloc;
        if (old + 1u == (gen + 1u) * nloc) {
            __builtin_amdgcn_fence(__ATOMIC_RELEASE, "agent");
            asm volatile("s_waitcnt vmcnt(0)" ::: "memory");
            const unsigned og = xb_add(&bar[XB_TOP], 1u);
            const unsigned tg = og / nx;
            if (og + 1u == (tg + 1u) * nx) xb_add(&bar[XB_TOPGEN], 1u);
            else XB_SPIN(xb_ld(&bar[XB_TOPGEN]) == tg, bar);
            __builtin_amdgcn_fence(__ATOMIC_ACQUIRE, "agent");
            xb_add(&bar[XB_XGEN(b.x)], 1u);
            asm volatile("s_waitcnt vmcnt(0)" ::: "memory");
        } else {
            XB_SPIN(xb_ld(&bar[XB_XGEN(b.x)]) == gen, bar);
            __builtin_amdgcn_fence(__ATOMIC_ACQUIRE, "agent");
            asm volatile("s_waitcnt vmcnt(0)" ::: "memory");
        }
    }
    __syncthreads();
}

__global__ void __launch_bounds__(NTHR, 2) fwd_megakernel(Params p) {
    extern __shared__ __attribute__((aligned(16))) unsigned char smem[];
    cg::grid_group grid = cg::this_grid();
    const int G = gridDim.x, bid = blockIdx.x;
    float* ldsf = (float*)smem;
    LAS unsigned char* ldsg = (LAS unsigned char*)smem;
    bf16_t* H = (bf16_t*)(p.ws + O_H);
    bf16_t* P = (bf16_t*)(p.ws + O_P);
    const float* MOD = (const float*)(p.ws + O_MOD);

    unsigned* barw = (unsigned*)(p.ws + O_BAR);
    volatile LAS unsigned* bst = (volatile LAS unsigned*)(ldsg + 131072);
    if (bid == 0) for (int i = threadIdx.x; i < XCD_BAR_WORDS; i += NTHR) barw[i] = 0u;
    if (threadIdx.x < 2) bst[threadIdx.x] = 0u;
    __syncthreads();
    grid.sync();
    (void)xcd_barrier_post(barw, bst);
#define GRID_SYNC() do { XcdBarrier b_; b_.bar = (unsigned*)(p.ws + O_BAR); b_.x = xb_xcc_id(); b_.st = (volatile LAS unsigned*)((LAS unsigned char*)smem + 131072); xcd_barrier(b_); } while (0)
    if (bid < 96) phase_mod(p, ldsf, 0, 1, 0, 96);
    else for (int i = bid - 96; i < 1920 + 320; i += G - 96) { if (i < 1920) conv_win(p, 0, i, ldsf); else conv_small(p, i - 1920, ldsf); }
    GRID_SYNC();
    phase_rows(p, 0, 0, NTOK, true);
    GRID_SYNC();

#pragma unroll 1
    for (int l = 0; l < NL; ++l) {
        const bool lastl = (l == NL - 1);
        const int nMrows = lastl ? NLAT / BM : NTOK / BM;
        const int nrows = lastl ? NLAT : NTOK;
        for (int rp = 0; rp < p.rep[0]; ++rp) {
            GemmDesc g; g.A0 = g.A1 = g.A2 = H; g.B0 = g.B1 = g.B2 = (const bf16_t*)(p.ws + O_WIN); g.lda = DM; g.K = DM;
            TileOrder S; S.init(NTOK / BM, DINP / BM, G, bid, 1);
            EpiP E; E.P = P; E.VT = (bf16_t*)(p.ws + O_VT);
            gemm_phase(ldsg, g, S, E);
        }
        GRID_SYNC();
        for (int rp = 1; rp < p.rep[13]; ++rp) GRID_SYNC();
        for (int rp = 0; rp < p.rep[1]; ++rp) phase_prep(p, l, smem);
        GRID_SYNC();
        if (bid < 64) {
            for (int rp = 0; rp < p.rep[2]; ++rp) scan_chain(p, l, bid, smem);
        } else {
            const int nsgu = lastl ? NLAT / 128 : NTOK / 128;
            const int nna = lastl ? 1024 : 1088;
            for (int rp = 0; rp < p.rep[3]; ++rp)
                for (int i = bid - 64; i < nsgu; i += G - 64) sgu_item(p, l, i, smem, rp == p.rep[3] - 1);
            float* rpbL = ldsf + 8192;
            for (int i = otid(); i < 8 * 465; i += NTHR) rpbL[i] = p.in[7][(size_t)l * 8 * 465 + i];
            __syncthreads();
            for (int rp = 0; rp < p.rep[4]; ++rp)
                for (int i = bid - 64; i < nna; i += G - 64) na_item(p, l, i, rp == p.rep[4] - 1, rpbL);
            __syncthreads();
            if (l == 0) for (int ci = bid - 64; ci < NCONV_LAYER; ci += G - 64) conv_layer(p, 0, ci, ldsf);
        }
        GRID_SYNC();
        for (int rp = 0; rp < p.rep[6]; ++rp) phase_readout(p, l, nrows);
        GRID_SYNC();
        for (int rp = 0; rp < p.rep[7]; ++rp) {
            GemmDesc g; g.A0 = P + OFF_Q; g.A1 = P + OFF_RW + 1024; g.A2 = P + OFF_SG;
            const bf16_t* wb = (const bf16_t*)(p.ws + O_WB); g.B0 = wb; g.B1 = wb + (size_t)DM * 512; g.B2 = wb + (size_t)2 * DM * 512; g.lda = LDP; g.K = 512;
            TileOrder S; S.init(nMrows, DM / BM, G, bid, 3);
            EpiMerge E; E.P = P; E.Y = H;
            gemm_phase(ldsg, g, S, E);
        }
        GRID_SYNC();
        for (int rp = 0; rp < p.rep[8]; ++rp) {
            GemmDesc g; g.A0 = g.A1 = g.A2 = H; g.B0 = g.B1 = g.B2 = (const bf16_t*)(p.ws + O_WOUT); g.lda = DM; g.K = DM;
            TileOrder S; S.init(nMrows, DM / BM, G, bid, 1);
            EpiRes E; E.p = p; E.mod = MOD + (size_t)l * 5 * 6144; E.gidx = 2; E.store = (rp == p.rep[8] - 1);
            gemm_phase(ldsg, g, S, E);
        }
        GRID_SYNC();
        for (int rp = 0; rp < p.rep[9]; ++rp) phase_rows(p, 1, l, nrows, rp == p.rep[9] - 1);
        GRID_SYNC();
        for (int rp = 0; rp < p.rep[10]; ++rp) {
            GemmDesc g; g.A0 = g.A1 = g.A2 = H; g.B0 = g.B1 = g.B2 = (const bf16_t*)(p.ws + O_WGU); g.lda = DM; g.K = DM;
            TileOrder S; S.init(nMrows, 2 * DFF / BM, G, bid, 1);
            EpiGlu E; E.HID = P;
            gemm_phase(ldsg, g, S, E);
        }
        GRID_SYNC();
        for (int rp = 0; rp < p.rep[11]; ++rp) {
            GemmDesc g; g.A0 = g.A1 = g.A2 = P; g.B0 = g.B1 = g.B2 = (const bf16_t*)(p.ws + O_WDN) + (size_t)(l & 1) * DM * DFF; g.lda = DFF; g.K = DFF;
            TileOrder S; S.init(nMrows, DM / BM, G, bid, 1);
            EpiRes E; E.p = p; E.mod = MOD + (size_t)l * 5 * 6144; E.gidx = 5; E.store = (rp == p.rep[11] - 1);
            gemm_phase(ldsg, g, S, E);
        }
        if (!lastl && bid >= 16) {
            if (bid < 112) phase_mod(p, ldsf, l + 1, 1, 16, 96);
            else for (int rp = 0; rp < p.rep[5]; ++rp)
                for (int ci = bid - 112; ci < NCONV_LAYER + 1920; ci += G - 112) { if (ci < NCONV_LAYER) conv_layer(p, l + 1, ci, ldsf); else conv_win(p, l + 1, ci - NCONV_LAYER, ldsf); }
        }
        GRID_SYNC();
        for (int rp = 0; rp < p.rep[12]; ++rp) phase_rows(p, 2, l, nrows, rp == p.rep[12] - 1);
        GRID_SYNC();
    }
}

extern "C" void kernel_launch(void* const* d_in, const int* in_sizes, int n_in, void* d_out, int out_size, void* d_ws, size_t ws_size, hipStream_t stream) {
    static int grid_blocks = 0;
    if (!grid_blocks) {
        int dev = 0, cus = 0, per_cu = 0;
        hipGetDevice(&dev);
        hipDeviceGetAttribute(&cus, hipDeviceAttributeMultiprocessorCount, dev);
        hipFuncSetAttribute((const void*)fwd_megakernel, hipFuncAttributeMaxDynamicSharedMemorySize, SMEM_BYTES);
        hipOccupancyMaxActiveBlocksPerMultiprocessor(&per_cu, fwd_megakernel, NTHR, SMEM_BYTES);
        if (per_cu < 1) per_cu = 1;
        if (per_cu > 1) per_cu = 1;
        grid_blocks = cus * per_cu;
    }
    if (ws_size < WS_TOTAL) { fprintf(stderr, "workspace too small: %zu < %zu\n", ws_size, (size_t)WS_TOTAL); return; }
    Params p{};
    for (int i = 0; i < 32; ++i) p.in[i] = (const float*)d_in[i];
    p.out = (float*)d_out;
    p.ws = (unsigned char*)d_ws;
    for (int i = 0; i < 16; ++i) p.rep[i] = 1;
#ifdef REPK
    p.rep[REPK] = 2;
#endif
    void* args[] = {&p};
    hipError_t e = hipLaunchCooperativeKernel((void*)fwd_megakernel, dim3(grid_blocks), dim3(NTHR), args, SMEM_BYTES, stream);
    if (e != hipSuccess) fprintf(stderr, "cooperative launch failed: %s (grid %d)\n", hipGetErrorString(e), grid_blocks);
}
```

```cpp
#include <hip/hip_runtime.h>
#include <hip/hip_cooperative_groups.h>
#include <cstdio>
namespace cg = cooperative_groups;

#define LAS __attribute__((address_space(3)))
typedef unsigned short bf16_t;
typedef short bf16x8 __attribute__((ext_vector_type(8)));
typedef short bf16x4 __attribute__((ext_vector_type(4)));
typedef float f32x4 __attribute__((ext_vector_type(4)));
typedef unsigned u32x4 __attribute__((ext_vector_type(4)));
typedef unsigned u32x2 __attribute__((ext_vector_type(2)));

#ifndef EN_NA
#define EN_NA 1
#endif
#ifndef EN_RWKV
#define EN_RWKV 1
#endif
#ifndef EN_SGU
#define EN_SGU 1
#endif
#ifndef EN_MIX
#define EN_MIX 1
#endif
#ifndef EN_FFN
#define EN_FFN 1
#endif

constexpr int DM = 1024, NB = 4, SEQ = 4096, NL = 4, CTXL = 256;
constexpr int NLAT = NB * SEQ, NCTX = NB * CTXL, NTOK = NLAT + NCTX;
constexpr int DIN = 7552, DINP = 7680, LDP = 7552;
constexpr int OFF_Q = 3072, OFF_K = 3584, OFF_V = 4096, OFF_RW = 4608, OFF_SG = 6528;
constexpr int DFF = 2816;
constexpr float ALPHA = 1.681792830507429f;
constexpr int NTHR = 512;
constexpr int SMEM_BYTES = 131072 + 16;

constexpr size_t SZ_TOK512 = (size_t)NTOK * 512 * 2;
constexpr size_t O_XC = 0;
constexpr size_t O_MOD = O_XC + (size_t)NCTX * DM * 4;
constexpr size_t O_H = O_MOD + (size_t)NL * 5 * 6144 * 4;
constexpr size_t O_P = O_H + (size_t)NTOK * DM * 2;
constexpr size_t O_WIN = O_P + (size_t)NTOK * LDP * 2;
constexpr size_t O_WB = O_WIN + (size_t)DINP * DM * 2;
constexpr size_t O_WOUT = O_WB + (size_t)3 * DM * 512 * 2;
constexpr size_t O_WGU = O_WOUT + (size_t)DM * DM * 2;
constexpr size_t O_WDN = O_WGU + (size_t)2 * DFF * DM * 2;
constexpr size_t O_W2T = O_WDN + (size_t)2 * DM * DFF * 2;
constexpr size_t O_A2T = O_W2T + (size_t)NL * 2 * 512 * 64 * 2;
constexpr size_t O_G2T = O_A2T + (size_t)NL * 2 * 512 * 64 * 2;
constexpr size_t O_SGW = O_G2T + (size_t)NL * 512 * 128 * 2;
constexpr size_t O_VT = O_SGW + (size_t)NL * 8 * 128 * 128 * 2;
constexpr size_t O_VS = O_VT + SZ_TOK512;
constexpr size_t O_KK = O_VS + SZ_TOK512;
constexpr size_t O_OMD = O_KK + SZ_TOK512;
constexpr size_t O_AA = O_OMD + 2 * SZ_TOK512;
constexpr size_t O_GG = O_AA + 2 * SZ_TOK512;
constexpr size_t O_BAR = O_GG + SZ_TOK512;
constexpr size_t WS_TOTAL = O_BAR + 16384;
static_assert(WS_TOTAL <= 494927872ull, "workspace too large");

struct Params {
    const float* in[32];
    float* out;
    unsigned char* ws;
    int rep[16];
};

__device__ __forceinline__ int otid() { int t = threadIdx.x; asm volatile("" : "+v"(t)); return t; }
__device__ __forceinline__ float bf2f(bf16_t b) { return __uint_as_float(((unsigned)b) << 16); }
typedef __bf16 bf16v2_t __attribute__((ext_vector_type(2)));
typedef float f32v2_t __attribute__((ext_vector_type(2)));
__device__ __forceinline__ unsigned cvt_pk_bf16(float lo, float hi) { const f32v2_t f = {lo, hi}; const bf16v2_t b = __builtin_convertvector(f, bf16v2_t); return __builtin_bit_cast(unsigned, b); }
__device__ __forceinline__ bf16_t f2bf(float f) { return (bf16_t)(cvt_pk_bf16(f, 0.f) & 0xffffu); }
__device__ __forceinline__ void unpack8(const u32x4 v, float (&f)[8]) {
#pragma unroll
    for (int i = 0; i < 4; ++i) { f[2 * i] = __uint_as_float(v[i] << 16); f[2 * i + 1] = __uint_as_float(v[i] & 0xffff0000u); }
}
__device__ __forceinline__ u32x4 pack8(const float (&f)[8]) {
    u32x4 r;
#pragma unroll
    for (int i = 0; i < 4; ++i) r[i] = cvt_pk_bf16(f[2 * i], f[2 * i + 1]);
    return r;
}
__device__ __forceinline__ void unpack4(const u32x2 v, float (&f)[4]) {
    f[0] = __uint_as_float(v[0] << 16); f[1] = __uint_as_float(v[0] & 0xffff0000u);
    f[2] = __uint_as_float(v[1] << 16); f[3] = __uint_as_float(v[1] & 0xffff0000u);
}
__device__ __forceinline__ float sigmoidf_(float x) { return __builtin_amdgcn_rcpf(1.f + __expf(-x)); }
__device__ __forceinline__ float gelu_tanh(float x) { const float y = 0.7978845608028654f * (x + 0.044715f * x * x * x); return x * __builtin_amdgcn_rcpf(1.f + __expf(-2.f * y)); }
__device__ __forceinline__ float* xrow(const Params& p, int row) { return row < NLAT ? p.out + (size_t)row * DM : (float*)(p.ws + O_XC) + (size_t)(row - NLAT) * DM; }
__device__ __forceinline__ int mod_batch(int row) { return row < NLAT ? (row >> 12) : 4; }

constexpr int BM = 256, BK = 64, HALF = 128, HTB = HALF * BK * 2, NXCD = 8, WGM = 8;
__device__ __forceinline__ int lds_byte(int r, int c) { const int st = (r >> 4) * 2 + (c >> 5), rr = r & 15, cc = c & 31, ob = rr * 64 + cc * 2; return st * 1024 + (ob ^ (((ob >> 9) & 1) << 5)); }
__device__ __forceinline__ void stage_rc(int b, int& R, int& C) { const int st = b / 1024, sb = b % 1024, swz = sb ^ (((sb >> 9) & 1) << 5); R = (st >> 1) * 16 + swz / 64; C = (st & 1) * 32 + (swz % 64) / 2; }
__device__ __forceinline__ int perm32(int rho) { const int n = rho >> 4, i = rho & 15; return 8 * (i >> 2) + 4 * n + (i & 3); }

struct Unit { int pm, pn, z; };
struct GemmDesc { const bf16_t* A0; const bf16_t* A1; const bf16_t* A2; const bf16_t* B0; const bf16_t* B1; const bf16_t* B2; int lda, K; };

struct TileOrder {
    int nM, nN, nwg, G, c, nz;
    __device__ void init(int nM_, int nN_, int G_, int c_, int nz_) { nM = nM_; nN = nN_; nwg = nM * nN; G = G_; c = c_; nz = nz_; }
    __device__ bool next(int i, Unit& u) const {
        const int it = i / nz; u.z = i - it * nz;
        const long L = (long)it * G + c; if (L >= nwg) return false;
        int wgid = (int)L; { const int q = nwg / NXCD, r = nwg % NXCD, xcd = wgid % NXCD, off = wgid / NXCD; wgid = (xcd < r ? xcd * (q + 1) : r * (q + 1) + (xcd - r) * q) + off; }
        const int nig = WGM * nN, gid = wgid / nig, fm = gid * WGM, gsz = (nM - fm) < WGM ? (nM - fm) : WGM;
        u.pm = fm + ((wgid % nig) % gsz); u.pn = (wgid % nig) / gsz; return true;
    }
};

typedef f32x4 Acc[2][2][4][2];
__device__ __forceinline__ void zero_acc(Acc& acc) {
#pragma unroll
    for (int a = 0; a < 2; ++a)
#pragma unroll
        for (int b = 0; b < 2; ++b)
#pragma unroll
            for (int m = 0; m < 4; ++m)
#pragma unroll
                for (int n = 0; n < 2; ++n) acc[a][b][m][n] = (f32x4){0.f, 0.f, 0.f, 0.f};
}

struct EpiP {
    static constexpr bool PERM = true;
    bf16_t* P; bf16_t* VT;
    __device__ __forceinline__ void operator()(Acc& acc, const Unit& u, int wr, int wc, int fr, int fq) const {
        const int row0 = u.pm * BM + wr * 64 + fr, colb = u.pn * BM + wc * 32 + 8 * fq;
        const bool isv = (u.pn == 16 || u.pn == 17);
#pragma unroll
        for (int ai = 0; ai < 2; ++ai)
#pragma unroll
            for (int m = 0; m < 4; ++m) {
                const int row = row0 + ai * HALF + m * 16;
#pragma unroll
                for (int bj = 0; bj < 2; ++bj) {
                    const int col = colb + bj * HALF;
                    const f32x4 v0 = acc[ai][bj][m][0], v1 = acc[ai][bj][m][1];
                    u32x4 o; o[0] = cvt_pk_bf16(v0[0], v0[1]); o[1] = cvt_pk_bf16(v0[2], v0[3]); o[2] = cvt_pk_bf16(v1[0], v1[1]); o[3] = cvt_pk_bf16(v1[2], v1[3]);
                    if (col < DIN) *(u32x4*)(P + (size_t)row * LDP + col) = o;
                    if (isv) {
                        bf16_t* vt = VT + (size_t)(col - OFF_V) * NTOK + row;
#pragma unroll
                        for (int e = 0; e < 4; ++e) { vt[(size_t)(2 * e) * NTOK] = (bf16_t)(o[e] & 0xffffu); vt[(size_t)(2 * e + 1) * NTOK] = (bf16_t)(o[e] >> 16); }
                    }
                }
            }
        zero_acc(acc);
    }
};

struct EpiMerge {
    static constexpr bool PERM = true;
    const bf16_t* P; bf16_t* Y;
    __device__ __forceinline__ void operator()(Acc& acc, const Unit& u, int wr, int wc, int fr, int fq) const {
        const int row0 = u.pm * BM + wr * 64 + fr, colb = u.pn * BM + wc * 32 + 8 * fq;
        const int zb = u.z < 2 ? 1024 : 0;
#pragma unroll
        for (int ai = 0; ai < 2; ++ai) {
            u32x4 ga[4][2], gb[4][2];
#pragma unroll
            for (int m = 0; m < 4; ++m)
#pragma unroll
                for (int bj = 0; bj < 2; ++bj) {
                    const bf16_t* gp = P + (size_t)(row0 + ai * HALF + m * 16) * LDP + u.z * 1024 + colb + bj * HALF;
                    ga[m][bj] = *(const u32x4*)gp; gb[m][bj] = *(const u32x4*)(gp + zb);
                }
#pragma unroll
            for (int m = 0; m < 4; ++m)
#pragma unroll
                for (int bj = 0; bj < 2; ++bj) {
                    float fa[8], fb[8], sc[8];
                    unpack8(ga[m][bj], fa); unpack8(gb[m][bj], fb);
#pragma unroll
                    for (int e = 0; e < 8; ++e) { const float ra = __builtin_amdgcn_rcpf(1.f + __expf(-fa[e])); sc[e] = u.z < 2 ? (1.f + __expf(-fb[e])) * ra : ra; }
                    f32x4 v0 = acc[ai][bj][m][0], v1 = acc[ai][bj][m][1];
#pragma unroll
                    for (int e = 0; e < 4; ++e) { v0[e] *= sc[e]; v1[e] *= sc[4 + e]; }
                    if (u.z == 2) {
                        u32x4 o; o[0] = cvt_pk_bf16(v0[0], v0[1]); o[1] = cvt_pk_bf16(v0[2], v0[3]); o[2] = cvt_pk_bf16(v1[0], v1[1]); o[3] = cvt_pk_bf16(v1[2], v1[3]);
                        *(u32x4*)(Y + (size_t)(row0 + ai * HALF + m * 16) * DM + colb + bj * HALF) = o;
                        acc[ai][bj][m][0] = (f32x4){0.f, 0.f, 0.f, 0.f}; acc[ai][bj][m][1] = (f32x4){0.f, 0.f, 0.f, 0.f};
                    } else { acc[ai][bj][m][0] = v0; acc[ai][bj][m][1] = v1; }
                }
        }
    }
};

struct EpiRes {
    static constexpr bool PERM = false;
    Params p; const float* mod;
    int gidx; bool store;
    __device__ __forceinline__ void operator()(Acc& acc, const Unit& u, int wr, int wc, int fr, int fq) const {
        const int row0 = u.pm * BM + wr * 64 + fr, colb = u.pn * BM + wc * 32 + 4 * fq;
        const float* gm = mod + mod_batch(u.pm * BM) * 6144 + gidx * 1024;
        f32x4 gv[2][2];
#pragma unroll
        for (int bj = 0; bj < 2; ++bj)
#pragma unroll
            for (int n = 0; n < 2; ++n) gv[bj][n] = *(const f32x4*)(gm + colb + bj * HALF + n * 16);
#pragma unroll
        for (int ai = 0; ai < 2; ++ai) {
            f32x4 xv[4][2][2];
#pragma unroll
            for (int m = 0; m < 4; ++m) {
                const float* rp = xrow(p, row0 + ai * HALF + m * 16) + colb;
#pragma unroll
                for (int bj = 0; bj < 2; ++bj)
#pragma unroll
                    for (int n = 0; n < 2; ++n) xv[m][bj][n] = *(const f32x4*)(rp + bj * HALF + n * 16);
            }
#pragma unroll
            for (int m = 0; m < 4; ++m) {
                float* rp = xrow(p, row0 + ai * HALF + m * 16) + colb;
#pragma unroll
                for (int bj = 0; bj < 2; ++bj)
#pragma unroll
                    for (int n = 0; n < 2; ++n) if (store) *(f32x4*)(rp + bj * HALF + n * 16) = xv[m][bj][n] * ALPHA + gv[bj][n] * acc[ai][bj][m][n];
            }
        }
        zero_acc(acc);
    }
};

struct EpiGlu {
    static constexpr bool PERM = true;
    bf16_t* HID;
    __device__ __forceinline__ void operator()(Acc& acc, const Unit& u, int wr, int wc, int fr, int fq) const {
        const int row0 = u.pm * BM + wr * 64 + fr, col = u.pn * HALF + wc * 32 + 8 * fq;
#pragma unroll
        for (int ai = 0; ai < 2; ++ai)
#pragma unroll
            for (int m = 0; m < 4; ++m) {
                const int row = row0 + ai * HALF + m * 16;
                float o[8];
#pragma unroll
                for (int n = 0; n < 2; ++n)
#pragma unroll
                    for (int e = 0; e < 4; ++e) { const float g = acc[ai][0][m][n][e], up = acc[ai][1][m][n][e]; o[n * 4 + e] = g * __builtin_amdgcn_rcpf(1.f + __expf(-g)) * up; }
                *(u32x4*)(HID + (size_t)row * DFF + col) = pack8(o);
            }
        zero_acc(acc);
    }
};

template <class Epi>
__device__ __forceinline__ void gemm_phase(LAS unsigned char* lds, const GemmDesc g, const TileOrder& S, const Epi& E) {
    const int tid = otid(), wid = __builtin_amdgcn_readfirstlane(tid >> 6), lane = tid & 63, wr = wid >> 2, wc = wid & 3, fr = lane & 15, fq = lane >> 4;
    const int K = g.K, nt = K / BK, lda = g.lda;
    unsigned voffA[2], voffB[2];
#pragma unroll
    for (int i = 0; i < 2; ++i) { int R, C; stage_rc(tid * 16 + i * 8192, R, C); const int Rb = Epi::PERM ? ((R & ~31) + perm32(R & 31)) : R;
        voffA[i] = (unsigned)(R * lda + C) * 2u; voffB[i] = (unsigned)(Rb * K + C) * 2u; }
    const size_t kstep = (size_t)(BK * 2);
    const size_t hstepA = (size_t)HALF * lda * 2, hstepB = (size_t)HALF * K * 2;
    const size_t tstepA = 2 * hstepA, tstepB = 2 * hstepB;
    const unsigned ldsw = (unsigned)wid * 1024u;
    const int aoff = lds_byte(wr * 64 + fr, fq * 8), boff = lds_byte(wc * 32 + fr, fq * 8);
#define PG8_SA(b, h) (((b) * 2 + (h)) * HTB)
#define PG8_SB(b, h) ((4 + (b) * 2 + (h)) * HTB)
#define PG8_STAGE(bufoff, gbase, voff) do { _Pragma("unroll") for (int _i = 0; _i < 2; ++_i) \
        __builtin_amdgcn_global_load_lds((const unsigned*)((const char*)(gbase) + (voff)[_i]), (LAS unsigned*)(lds + (bufoff) + ldsw + _i * 8192), 16, 0, 0); } while (0)
#define PG8_LDA(dst, b, h) do { _Pragma("unroll") for (int m = 0; m < 4; ++m) _Pragma("unroll") for (int k = 0; k < 2; ++k) dst[m][k] = *(const LAS bf16x8*)(lds + PG8_SA(b, h) + aoff + m * 2048 + k * 1024); } while (0)
#define PG8_LDB(dst, b, h) do { _Pragma("unroll") for (int n = 0; n < 2; ++n) _Pragma("unroll") for (int k = 0; k < 2; ++k) dst[n][k] = *(const LAS bf16x8*)(lds + PG8_SB(b, h) + boff + n * 2048 + k * 1024); } while (0)
#define PG8_MMA(ai, bj, At, Bt) do { __builtin_amdgcn_s_setprio(1); _Pragma("unroll") for (int m = 0; m < 4; ++m) _Pragma("unroll") for (int n = 0; n < 2; ++n) _Pragma("unroll") for (int k = 0; k < 2; ++k) \
        acc[ai][bj][m][n] = __builtin_amdgcn_mfma_f32_16x16x32_bf16(Bt[n][k], At[m][k], acc[ai][bj][m][n], 0, 0, 0); __builtin_amdgcn_s_setprio(0); } while (0)
#define PG8_WAIT_V(n) asm volatile("s_waitcnt vmcnt(" #n ")" ::: "memory")
#define PG8_WAIT_L(n) asm volatile("s_waitcnt lgkmcnt(" #n ")" ::: "memory")
#define PG8_BAR __builtin_amdgcn_s_barrier()
#define PG8_SCHED __builtin_amdgcn_sched_barrier(0)
    Unit cur, nxt; int ui = 0;
    if (!S.next(0, cur)) return;
    Acc acc;
    zero_acc(acc);
    bf16x8 At[4][2], B0[2][2], B1[2][2];
    const char* cA = (const char*)(cur.z == 0 ? g.A0 : cur.z == 1 ? g.A1 : g.A2) + (size_t)cur.pm * tstepA;
    const char* cB = (const char*)(cur.z == 0 ? g.B0 : cur.z == 1 ? g.B1 : g.B2) + (size_t)cur.pn * tstepB;
    PG8_STAGE(PG8_SB(0, 0), cB, voffB); PG8_STAGE(PG8_SB(0, 1), cB + hstepB, voffB); PG8_STAGE(PG8_SA(0, 0), cA, voffA); PG8_STAGE(PG8_SA(0, 1), cA + hstepA, voffA);
    if (wr == 1) PG8_BAR;
    PG8_WAIT_V(2); PG8_BAR;
    PG8_STAGE(PG8_SB(1, 0), cB + kstep, voffB); PG8_STAGE(PG8_SA(1, 0), cA + kstep, voffA); PG8_STAGE(PG8_SB(1, 1), cB + hstepB + kstep, voffB);
    PG8_WAIT_V(6); PG8_BAR;
    for (;;) {
        const bool has_next = S.next(ui + 1, nxt);
        const char* nA = has_next ? (const char*)(nxt.z == 0 ? g.A0 : nxt.z == 1 ? g.A1 : g.A2) + (size_t)nxt.pm * tstepA : cA;
        const char* nB = has_next ? (const char*)(nxt.z == 0 ? g.B0 : nxt.z == 1 ? g.B1 : g.B2) + (size_t)nxt.pn * tstepB : cB;
        for (int t = 0; t < nt; t += 2) {
            const bool last = (t == nt - 2);
            const char* a1 = cA + (size_t)(t + 1) * kstep;
            const char* a2 = last ? nA : cA + (size_t)(t + 2) * kstep; const char* b2 = last ? nB : cB + (size_t)(t + 2) * kstep;
            const char* a3 = a2 + kstep; const char* b3 = b2 + kstep;
            PG8_LDB(B0, 0, 0); PG8_LDB(B1, 0, 1); PG8_SCHED; PG8_LDA(At, 0, 0); PG8_STAGE(PG8_SA(1, 1), a1 + hstepA, voffA);
            PG8_WAIT_V(8); PG8_WAIT_L(0); PG8_BAR; PG8_MMA(0, 0, At, B0); PG8_MMA(0, 1, At, B1); PG8_BAR; PG8_SCHED;
            PG8_LDA(At, 0, 1); PG8_STAGE(PG8_SB(0, 0), b2, voffB); PG8_STAGE(PG8_SB(0, 1), b2 + hstepB, voffB); PG8_STAGE(PG8_SA(0, 0), a2, voffA);
            PG8_WAIT_V(8); PG8_WAIT_L(0); PG8_BAR; PG8_MMA(1, 0, At, B0); PG8_MMA(1, 1, At, B1); PG8_BAR; PG8_SCHED;
            PG8_LDB(B0, 1, 0); PG8_LDB(B1, 1, 1); PG8_SCHED; PG8_LDA(At, 1, 0); PG8_STAGE(PG8_SA(0, 1), a2 + hstepA, voffA);
            PG8_WAIT_V(8); PG8_WAIT_L(0); PG8_BAR; PG8_MMA(0, 0, At, B0); PG8_MMA(0, 1, At, B1); PG8_BAR; PG8_SCHED;
            PG8_LDA(At, 1, 1); PG8_STAGE(PG8_SB(1, 0), b3, voffB); PG8_STAGE(PG8_SB(1, 1), b3 + hstepB, voffB); PG8_STAGE(PG8_SA(1, 0), a3, voffA);
            PG8_WAIT_V(8); PG8_WAIT_L(0); PG8_BAR; PG8_MMA(1, 0, At, B0); PG8_MMA(1, 1, At, B1); PG8_BAR; PG8_SCHED;
        }
        if (wr == 0) PG8_BAR;
        E(acc, cur, wr, wc, fr, fq);
        if (!has_next) break;
        cur = nxt; cA = nA; cB = nB; ++ui;
        if (wr == 1) PG8_BAR;
    }
    PG8_WAIT_V(0);
    PG8_BAR;
#undef PG8_SA
#undef PG8_SB
#undef PG8_STAGE
#undef PG8_LDA
#undef PG8_LDB
#undef PG8_MMA
#undef PG8_WAIT_V
#undef PG8_WAIT_L
#undef PG8_BAR
#undef PG8_SCHED
}

__device__ void phase_mod(const Params& p, float* lds, int l0, int nl, int b0, int nb) {
    const int tid = otid();
    for (int i = tid; i < 5 * 1024; i += NTHR) { const float c = i < 4096 ? p.in[1][i] : p.in[3][i - 4096]; lds[i] = c / (1.f + __expf(-c)); }
    __syncthreads();
    float* red = lds + 5 * 1024;
    float* MOD = (float*)(p.ws + O_MOD);
    const int col = tid & 63, kp = tid >> 6;
    for (int item = (int)blockIdx.x - b0; item < nl * 96; item += nb) {
        const int l = l0 + item / 96, j0 = (item % 96) * 64;
        const float* w = p.in[4] + ((size_t)l * 1024 + kp * 128) * 6144 + j0 + col;
        float a0 = 0.f, a1 = 0.f, a2 = 0.f, a3 = 0.f, a4 = 0.f;
        const float* s = lds + kp * 128;
#pragma unroll 16
        for (int k = 0; k < 128; ++k) { const float wv = w[(size_t)k * 6144]; a0 += s[k] * wv; a1 += s[1024 + k] * wv; a2 += s[2048 + k] * wv; a3 += s[3072 + k] * wv; a4 += s[4096 + k] * wv; }
        red[(kp * 5 + 0) * 64 + col] = a0; red[(kp * 5 + 1) * 64 + col] = a1; red[(kp * 5 + 2) * 64 + col] = a2; red[(kp * 5 + 3) * 64 + col] = a3; red[(kp * 5 + 4) * 64 + col] = a4;
        __syncthreads();
        if (tid < 320) {
            const int s5 = tid >> 6, cc = tid & 63;
            float v = p.in[5][l * 6144 + j0 + cc];
#pragma unroll
            for (int q = 0; q < 8; ++q) v += red[(q * 5 + s5) * 64 + cc];
            MOD[((size_t)l * 5 + s5) * 6144 + j0 + cc] = v;
        }
        __syncthreads();
    }
}

struct ConvJob { const float* src; bf16_t* dst; int K, ldsrc, nvalid, mode; };
__device__ void conv_tile(const ConvJob& j, int kt, int ntile, float* lds) {
    const int tid = otid();
    const int k0 = kt * 64, n0 = ntile * 64;
    int scol = n0; bool valid = n0 < j.nvalid;
    if (j.mode == 1) { const int pn = n0 >> 8, bj = (n0 >> 7) & 1, j0 = n0 & 127; scol = bj * DFF + pn * 128 + j0; }
    {
        const int r = tid >> 3, c8 = (tid & 7) * 8;
        f32x4 v0 = {0.f, 0.f, 0.f, 0.f}, v1 = {0.f, 0.f, 0.f, 0.f};
        if (valid) { const float* sp = j.src + (size_t)(k0 + r) * j.ldsrc + scol + c8; v0 = *(const f32x4*)sp; v1 = *(const f32x4*)(sp + 4); }
        float* t = lds + r * 65 + c8;
        t[0] = v0[0]; t[1] = v0[1]; t[2] = v0[2]; t[3] = v0[3]; t[4] = v1[0]; t[5] = v1[1]; t[6] = v1[2]; t[7] = v1[3];
    }
    __syncthreads();
    {
        const int n = tid >> 3, k8 = (tid & 7) * 8;
        float f[8];
#pragma unroll
        for (int e = 0; e < 8; ++e) f[e] = lds[(k8 + e) * 65 + n];
        *(u32x4*)(j.dst + (size_t)(n0 + n) * j.K + k0 + k8) = pack8(f);
    }
    __syncthreads();
}
__device__ void conv_win(const Params& p, int l, int idx, float* lds) {
    ConvJob j; j.src = p.in[6] + (size_t)l * DM * DIN; j.dst = (bf16_t*)(p.ws + O_WIN); j.K = DM; j.ldsrc = DIN; j.nvalid = DIN; j.mode = 0;
    conv_tile(j, idx & 15, idx >> 4, lds);
}
__device__ void conv_small(const Params& p, int idx, float* lds) {
    const int tid = otid();
    if (idx < 128) {
        const int which = idx >> 6, r = idx & 63, ld = r >> 3, ntile = r & 7;
        ConvJob j; j.src = p.in[which ? 13 : 11] + (size_t)ld * 64 * 512; j.dst = (bf16_t*)(p.ws + (which ? O_A2T : O_W2T)) + (size_t)ld * 512 * 64; j.K = 64; j.ldsrc = 512; j.nvalid = 512; j.mode = 0;
        conv_tile(j, 0, ntile, lds);
    } else if (idx < 192) {
        const int r = idx - 128, l = r >> 4, kt = (r >> 3) & 1, ntile = r & 7;
        ConvJob j; j.src = p.in[14] + (size_t)l * 128 * 512; j.dst = (bf16_t*)(p.ws + O_G2T) + (size_t)l * 512 * 128; j.K = 128; j.ldsrc = 512; j.nvalid = 512; j.mode = 0;
        conv_tile(j, kt, ntile, lds);
    } else {
        const int r = idx - 192;
        const float* s = p.in[22] + (size_t)r * 4096 + tid * 8;
        float f[8]; const f32x4 v0 = *(const f32x4*)s, v1 = *(const f32x4*)(s + 4);
        f[0] = v0[0]; f[1] = v0[1]; f[2] = v0[2]; f[3] = v0[3]; f[4] = v1[0]; f[5] = v1[1]; f[6] = v1[2]; f[7] = v1[3];
        *(u32x4*)((bf16_t*)(p.ws + O_SGW) + (size_t)r * 4096 + tid * 8) = pack8(f);
    }
}
constexpr int NCONV_LAYER = 384 + 256 + 1408 + 704;
__device__ void conv_layer(const Params& p, int l, int idx, float* lds) {
    ConvJob j; j.mode = 0;
    if (idx < 384) { const int br = idx >> 7, r = idx & 127; j.src = p.in[24] + ((size_t)l * 3 + br) * 512 * DM; j.dst = (bf16_t*)(p.ws + O_WB) + (size_t)br * DM * 512; j.K = 512; j.ldsrc = DM; j.nvalid = DM; conv_tile(j, r & 7, r >> 3, lds); return; }
    idx -= 384;
    if (idx < 256) { j.src = p.in[25] + (size_t)l * DM * DM; j.dst = (bf16_t*)(p.ws + O_WOUT); j.K = DM; j.ldsrc = DM; j.nvalid = DM; conv_tile(j, idx & 15, idx >> 4, lds); return; }
    idx -= 256;
    if (idx < 1408) { j.src = p.in[30] + (size_t)l * DM * 2 * DFF; j.dst = (bf16_t*)(p.ws + O_WGU); j.K = DM; j.ldsrc = 2 * DFF; j.nvalid = 2 * DFF; j.mode = 1; conv_tile(j, idx & 15, idx >> 4, lds); return; }
    idx -= 1408;
    { j.src = p.in[31] + (size_t)l * DFF * DM; j.dst = (bf16_t*)(p.ws + O_WDN) + (size_t)(l & 1) * DM * DFF; j.K = DFF; j.ldsrc = DM; j.nvalid = DM; conv_tile(j, idx % 44, idx / 44, lds); }
}

__device__ void phase_rows(const Params& p, int mode, int l, int nrows, bool store) {
    const int tid_ = otid(); const int lane = tid_ & 63, gw = blockIdx.x * 8 + (tid_ >> 6), nw = gridDim.x * 8;
    const float* MOD = (const float*)(p.ws + O_MOD);
    bf16_t* H = (bf16_t*)(p.ws + O_H);
    const float* lg = mode == 1 ? p.in[26] + l * DM : p.in[28] + l * DM;
    const float* lb = mode == 1 ? p.in[27] + l * DM : p.in[29] + l * DM;
    const int ml = mode == 2 ? l + 1 : l;
    const bool wh = !(mode == 2 && l == NL - 1);
    const int sci = mode == 1 ? 4 : 1, shi = mode == 1 ? 3 : 0;
#define ROWS_SRC(r) (mode == 0 ? ((r) < NLAT ? p.in[0] + (size_t)(r) * DM : p.in[2] + (size_t)((r) - NLAT) * DM) : (const float*)xrow(p, (r)))
    f32x4 nv[4];
    if (gw < nrows) { const float* s0 = ROWS_SRC(gw);
#pragma unroll
        for (int i = 0; i < 4; ++i) nv[i] = *(const f32x4*)(s0 + i * 256 + lane * 4); }
    for (int row = gw; row < nrows; row += nw) {
        float* xp = xrow(p, row);
        f32x4 v[4];
#pragma unroll
        for (int i = 0; i < 4; ++i) v[i] = nv[i];
        if (row + nw < nrows) { const float* s1 = ROWS_SRC(row + nw);
#pragma unroll
            for (int i = 0; i < 4; ++i) nv[i] = *(const f32x4*)(s1 + i * 256 + lane * 4); }
        if (mode == 0) {
#pragma unroll
            for (int i = 0; i < 4; ++i) { if (store) *(f32x4*)(xp + i * 256 + lane * 4) = v[i]; }
        } else {
            float s = 0.f;
#pragma unroll
            for (int i = 0; i < 4; ++i) s += v[i][0] + v[i][1] + v[i][2] + v[i][3];
#pragma unroll
            for (int o = 1; o < 64; o <<= 1) s += __shfl_xor(s, o);
            const float mu = s * (1.f / 1024.f);
            float q = 0.f;
#pragma unroll
            for (int i = 0; i < 4; ++i) { v[i] -= mu; q += v[i][0] * v[i][0] + v[i][1] * v[i][1] + v[i][2] * v[i][2] + v[i][3] * v[i][3]; }
#pragma unroll
            for (int o = 1; o < 64; o <<= 1) q += __shfl_xor(q, o);
            const float rs = rsqrtf(q * (1.f / 1024.f) + 1e-5f);
#pragma unroll
            for (int i = 0; i < 4; ++i) { const f32x4 g4 = *(const f32x4*)(lg + i * 256 + lane * 4), b4 = *(const f32x4*)(lb + i * 256 + lane * 4); v[i] = v[i] * rs * g4 + b4; if (store) *(f32x4*)(xp + i * 256 + lane * 4) = v[i]; }
        }
        if (wh && store) {
            const float* mb = MOD + ((size_t)ml * 5 + mod_batch(row)) * 6144;
#pragma unroll
            for (int i = 0; i < 4; ++i) {
                const f32x4 sc = *(const f32x4*)(mb + sci * 1024 + i * 256 + lane * 4), sh = *(const f32x4*)(mb + shi * 1024 + i * 256 + lane * 4);
                const f32x4 h = v[i] * (sc + 1.f) + sh;
                u32x2 o; o[0] = cvt_pk_bf16(h[0], h[1]); o[1] = cvt_pk_bf16(h[2], h[3]);
                *(u32x2*)(H + (size_t)row * DM + i * 256 + lane * 4) = o;
            }
        }
    }
}

constexpr int ALD = 392;
__device__ void phase_prep(const Params& p, int l, unsigned char* smem) {
    const int tid = otid(), wid = tid >> 6, lane = tid & 63, fr = lane & 15, fq = lane >> 4;
    const bf16_t* P = (const bf16_t*)(p.ws + O_P);
    bf16_t* RS = (bf16_t*)(p.ws + O_H); bf16_t* KS = RS + (size_t)NTOK * 512;
    bf16_t* VS = (bf16_t*)(p.ws + O_VS); bf16_t* KK = (bf16_t*)(p.ws + O_KK);
    bf16_t* OMD = (bf16_t*)(p.ws + O_OMD); bf16_t* AA = (bf16_t*)(p.ws + O_AA); bf16_t* GG = (bf16_t*)(p.ws + O_GG);
    const bf16_t* W2T = (const bf16_t*)(p.ws + O_W2T) + (size_t)l * 2 * 512 * 64;
    const bf16_t* A2T = (const bf16_t*)(p.ws + O_A2T) + (size_t)l * 2 * 512 * 64;
    const bf16_t* G2T = (const bf16_t*)(p.ws + O_G2T) + (size_t)l * 512 * 128;
    const float* mup = p.in[8] + l * 1920; const float* mun = p.in[9] + l * 1920;
    const float* kkw = p.in[15] + l * 512;
    const float* w0 = p.in[10] + l * 1024; const float* a0 = p.in[12] + l * 1024;
    bf16_t* At = (bf16_t*)smem;
    constexpr int PT = 68;
    for (int tile = blockIdx.x; tile < NTOK / PT; tile += gridDim.x) {
        {
            const int t0 = wid * 9, rbase = tile * PT + t0;
#pragma unroll 1
            for (int ch = 0; ch < 4; ++ch) {
                if (ch == 3 && lane >= 48) break;
                const int c = ch * 512 + lane * 8;
                u32x4 rw[11];
#pragma unroll
                for (int i = 0; i < 11; ++i) {
                    const int rr = min(max(rbase - 1 + i, 0), NTOK - 1);
                    rw[i] = *(const u32x4*)(P + (size_t)rr * LDP + OFF_RW + c);
                }
                const f32x4 mp0 = *(const f32x4*)(mup + c), mp1 = *(const f32x4*)(mup + c + 4), mn0 = *(const f32x4*)(mun + c), mn1 = *(const f32x4*)(mun + c + 4);
                f32x4 k0 = {0.f, 0.f, 0.f, 0.f}, k1 = {0.f, 0.f, 0.f, 0.f};
                if (ch == 1) { k0 = *(const f32x4*)(kkw + lane * 8); k1 = *(const f32x4*)(kkw + lane * 8 + 4); }
#pragma unroll
                for (int i = 0; i < 9; ++i) {
                    const int t = t0 + i, row = rbase + i;
                    if (t >= PT) break;
                    const bool first = row < NLAT ? ((row & 4095) == 0) : (((row - NLAT) & 255) == 0);
                    const bool lastt = row < NLAT ? ((row & 4095) == 4095) : (((row - NLAT) & 255) == 255);
                    float cur[8], prv[8], nxt[8], sv[8];
                    unpack8(rw[i + 1], cur); unpack8(rw[i], prv); unpack8(rw[i + 2], nxt);
#pragma unroll
                    for (int e = 0; e < 8; ++e) {
                        const float mp = e < 4 ? mp0[e] : mp1[e - 4], mn = e < 4 ? mn0[e] : mn1[e - 4];
                        const float pv = first ? 0.f : prv[e], nv = lastt ? 0.f : nxt[e];
                        sv[e] = cur[e] + mp * (pv - cur[e]) + mn * (nv - cur[e]);
                    }
                    if (ch == 0) *(u32x4*)(RS + (size_t)row * 512 + lane * 8) = pack8(sv);
                    else if (ch == 1) {
                        *(u32x4*)(KS + (size_t)row * 512 + lane * 8) = pack8(sv);
                        float kv[8], ss = 0.f;
#pragma unroll
                        for (int e = 0; e < 8; ++e) { kv[e] = sv[e] * (e < 4 ? k0[e] : k1[e - 4]); ss += kv[e] * kv[e]; }
                        ss += __shfl_xor(ss, 1); ss += __shfl_xor(ss, 2); ss += __shfl_xor(ss, 4);
                        const float rn = rsqrtf(ss + 1e-12f);
#pragma unroll
                        for (int e = 0; e < 8; ++e) kv[e] *= rn;
                        *(u32x4*)(KK + (size_t)row * 512 + lane * 8) = pack8(kv);
                    } else if (ch == 2) *(u32x4*)(VS + (size_t)row * 512 + lane * 8) = pack8(sv);
                    else {
                        const int cc = lane * 8;
                        if (cc < 128) {
#pragma unroll
                            for (int e = 0; e < 8; ++e) sv[e] = 1.f - 2.f * __builtin_amdgcn_rcpf(__expf(2.f * sv[e]) + 1.f);
                        } else if (cc >= 256) {
#pragma unroll
                            for (int e = 0; e < 8; ++e) sv[e] = sigmoidf_(sv[e]);
                        }
                        *(u32x4*)(At + t * ALD + cc) = pack8(sv);
                    }
                }
            }
        }
        __syncthreads();
#pragma unroll 1
        for (int mat = 0; mat < 5; ++mat) {
            const int dir = mat & 1;
            const bf16_t* Wt = mat < 2 ? W2T + (size_t)dir * 512 * 64 : mat < 4 ? A2T + (size_t)dir * 512 * 64 : G2T;
            const int Kd = mat < 4 ? 64 : 128;
            const int koff = mat < 2 ? dir * 64 : mat < 4 ? 128 + dir * 64 : 256;
#pragma unroll 1
            for (int nt_ = 0; nt_ < 4; ++nt_) {
                const int cb = wid * 64 + nt_ * 16;
                bf16x8 wf[4];
                const bf16_t* wp = Wt + (size_t)(cb + fr) * Kd + fq * 8;
                wf[0] = *(const bf16x8*)wp; wf[1] = *(const bf16x8*)(wp + 32);
                if (mat == 4) { wf[2] = *(const bf16x8*)(wp + 64); wf[3] = *(const bf16x8*)(wp + 96); } else { wf[2] = wf[0]; wf[3] = wf[1]; }
                const int c4 = cb + fq * 4;
                f32x4 bias = {0.f, 0.f, 0.f, 0.f};
                if (mat < 2) bias = *(const f32x4*)(w0 + dir * 512 + c4); else if (mat < 4) bias = *(const f32x4*)(a0 + dir * 512 + c4);
#pragma unroll
                for (int tt = 0; tt < 5; ++tt) {
                    const bf16_t* ap = At + (tt * 16 + fr) * ALD + koff + fq * 8;
                    f32x4 acc = {0.f, 0.f, 0.f, 0.f};
                    acc = __builtin_amdgcn_mfma_f32_16x16x32_bf16(wf[0], *(const bf16x8*)ap, acc, 0, 0, 0);
                    acc = __builtin_amdgcn_mfma_f32_16x16x32_bf16(wf[1], *(const bf16x8*)(ap + 32), acc, 0, 0, 0);
                    if (mat == 4) {
                        acc = __builtin_amdgcn_mfma_f32_16x16x32_bf16(wf[2], *(const bf16x8*)(ap + 64), acc, 0, 0, 0);
                        acc = __builtin_amdgcn_mfma_f32_16x16x32_bf16(wf[3], *(const bf16x8*)(ap + 96), acc, 0, 0, 0);
                    }
                    const int row = tile * PT + tt * 16 + fr;
                    float o[4];
                    if (mat < 2) {
#pragma unroll
                        for (int e = 0; e < 4; ++e) {
                            const float x = -(bias[e] + acc[e]);
                            const float ee = 0.6065306597126334f * __builtin_amdgcn_rcpf(1.f + __expf(x));
                            o[e] = 1.f - __expf(-ee);
                        }
                    } else if (mat < 4) {
#pragma unroll
                        for (int e = 0; e < 4; ++e) o[e] = sigmoidf_(bias[e] + acc[e]);
                    } else {
#pragma unroll
                        for (int e = 0; e < 4; ++e) o[e] = acc[e];
                    }
                    u32x2 ov; ov[0] = cvt_pk_bf16(o[0], o[1]); ov[1] = cvt_pk_bf16(o[2], o[3]);
                    bf16_t* dst = mat < 2 ? OMD + (size_t)dir * NTOK * 512 : mat < 4 ? AA + (size_t)dir * NTOK * 512 : GG;
                    if (tt * 16 + fr < PT) *(u32x2*)(dst + (size_t)row * 512 + c4) = ov;
                }
            }
        }
        __syncthreads();
    }
}

constexpr int SC_KT = 0, SC_RT = 2304, SC_KBT = 4608, SC_BBT = 6656, SC_VT = 8704, SC_TM = 10752, SC_BM = 11264, SC_E = 11776, SC_F = 12288, SC_WC = 12800, SC_SLOT = 13056;
constexpr int SC_SCR = 8 * SC_SLOT, SC_SCRSZ = 6144;
static_assert(SC_SCR + 4 * SC_SCRSZ <= 131072, "scan LDS");
union BF8 { u32x4 u; bf16x8 v; };
__device__ __forceinline__ bf16x8 pack4z(const f32x4 d) { BF8 r; r.u[0] = cvt_pk_bf16(d[0], d[1]); r.u[1] = cvt_pk_bf16(d[2], d[3]); r.u[2] = 0u; r.u[3] = 0u; return r.v; }
__device__ __forceinline__ bf16x8 ldx4z(const bf16_t* q) { const bf16x4 t = *(const bf16x4*)q; const bf16x4 z = {0, 0, 0, 0}; return __builtin_shufflevector(t, z, 0, 1, 2, 3, 4, 5, 6, 7); }
__device__ __forceinline__ void stD16(bf16_t* M, const f32x4 d, int fr, int fq) {
#pragma unroll
    for (int jj = 0; jj < 4; ++jj) M[(fq * 4 + jj) * 16 + fr] = f2bf(d[jj]);
    asm volatile("" ::: "memory");
}
struct ConsOps { bf16x4 kt[4], rt[4], kb[4], bb[4], bm, e, tm, f, vy, vy2; f32x4 wc[4]; };
__device__ __forceinline__ bf16x8 z8(const bf16x4 t) { const bf16x4 z = {0, 0, 0, 0}; return __builtin_shufflevector(t, z, 0, 1, 2, 3, 4, 5, 6, 7); }
#define MFMA16(X, Y, C) __builtin_amdgcn_mfma_f32_16x16x32_bf16((X), (Y), (C), 0, 0, 0)

__device__ void scan_chain(const Params& p, int l, int chain, unsigned char* smem) {
    const int tid = otid(), wid = __builtin_amdgcn_readfirstlane(tid >> 6), lane = tid & 63, fr = lane & 15, fq = lane >> 4;
    const int dir = chain >> 5, b = (chain >> 3) & 3, h = chain & 7;
    const bf16_t* RS = (const bf16_t*)(p.ws + O_H); const bf16_t* KS = RS + (size_t)NTOK * 512;
    const bf16_t* VS = (const bf16_t*)(p.ws + O_VS); const bf16_t* KK = (const bf16_t*)(p.ws + O_KK);
    const bf16_t* OMD = (const bf16_t*)(p.ws + O_OMD) + (size_t)dir * NTOK * 512; const bf16_t* AA = (const bf16_t*)(p.ws + O_AA) + (size_t)dir * NTOK * 512;
    bf16_t* P = (bf16_t*)(p.ws + O_P);
    const int rstep = dir ? -1 : 1;
    constexpr int NGRP = (CTXL + SEQ) / 64;
    f32x4 st[2][4];
#pragma unroll
    for (int vt = 0; vt < 2; ++vt)
#pragma unroll
        for (int kt = 0; kt < 4; ++kt) st[vt][kt] = (f32x4){0.f, 0.f, 0.f, 0.f};
    const int li = lane >> 2, c16 = (lane & 3) * 16;
    float ka16[16];
#pragma unroll
    for (int e = 0; e < 16; ++e) ka16[e] = p.in[16][l * 512 + h * 64 + c16 + e];
    u32x4 raw[12];
#define SCAN_ROW0(cc) (((cc) * 16) < 256 ? NLAT + b * 256 + (dir ? 255 - (cc) * 16 : (cc) * 16) : b * 4096 + (dir ? 4095 - ((cc) * 16 - 256) : ((cc) * 16 - 256)))
#define SCAN_LOADRAW(cc) do { const size_t o_ = (size_t)(SCAN_ROW0(cc) + li * rstep) * 512 + h * 64 + c16; \
        raw[0] = *(const u32x4*)(RS + o_); raw[1] = *(const u32x4*)(RS + o_ + 8); raw[2] = *(const u32x4*)(KS + o_); raw[3] = *(const u32x4*)(KS + o_ + 8); \
        raw[4] = *(const u32x4*)(VS + o_); raw[5] = *(const u32x4*)(VS + o_ + 8); raw[6] = *(const u32x4*)(KK + o_); raw[7] = *(const u32x4*)(KK + o_ + 8); \
        raw[8] = *(const u32x4*)(OMD + o_); raw[9] = *(const u32x4*)(OMD + o_ + 8); raw[10] = *(const u32x4*)(AA + o_); raw[11] = *(const u32x4*)(AA + o_ + 8); } while (0)
#pragma unroll
    for (int e = 0; e < 12; ++e) raw[e] = (u32x4){0u, 0u, 0u, 0u};
    const bool is_prod = (wid & 2) == 0;
    const int pj = (wid & 1) + ((wid >> 2) << 1);
    const int cw = wid & 1;
    if (is_prod) SCAN_LOADRAW(pj);
    if (is_prod) {
#pragma unroll 1
      for (int g = -1; g < NGRP; ++g) {
        {
            const int j = pj, gg = g + 1;
            if (gg < NGRP) for (int rp2 = 0; rp2 < p.rep[14]; ++rp2) {
                const int s0 = (gg * 4 + j) * 16;
                const int row0 = s0 < 256 ? NLAT + b * 256 + (dir ? 255 - s0 : s0) : b * 4096 + (dir ? 4095 - (s0 - 256) : (s0 - 256));
                unsigned char* slot = smem + ((gg & 1) * 4 + j) * SC_SLOT;
                unsigned char* scr = smem + SC_SCR + j * SC_SCRSZ;
                bf16_t* Kt = (bf16_t*)(slot + SC_KT); bf16_t* Rt = (bf16_t*)(slot + SC_RT);
                bf16_t* Kh = (bf16_t*)(scr); bf16_t* Bh = (bf16_t*)(scr + 2304);
                bf16_t* P1 = (bf16_t*)(scr + 4608); bf16_t* P2 = (bf16_t*)(scr + 5120); bf16_t* P4 = (bf16_t*)(scr + 5632);
                float* Wbuf = (float*)(slot + SC_KBT);
                const u32x4 vraw0 = raw[4], vraw1 = raw[5];
                const u32x4 cr0 = raw[0], cr1 = raw[1], ck0 = raw[2], ck1 = raw[3], cq0 = raw[6], cq1 = raw[7], ca0 = raw[10], ca1 = raw[11];
                f32x4 wown[4];
                {
                    float om[2][8];
                    unpack8(raw[8], om[0]); unpack8(raw[9], om[1]);
#pragma unroll
                    for (int hh = 0; hh < 2; ++hh) {
                        wown[hh * 2] = (f32x4){1.f - om[hh][0], 1.f - om[hh][1], 1.f - om[hh][2], 1.f - om[hh][3]};
                        wown[hh * 2 + 1] = (f32x4){1.f - om[hh][4], 1.f - om[hh][5], 1.f - om[hh][6], 1.f - om[hh][7]};
                        *(f32x4*)(Wbuf + li * 64 + c16 + hh * 8) = wown[hh * 2];
                        *(f32x4*)(Wbuf + li * 64 + c16 + hh * 8 + 4) = wown[hh * 2 + 1];
                    }
                }
                asm volatile("" ::: "memory");
                {
                    float wcol[16];
#pragma unroll
                    for (int i = 0; i < 16; ++i) wcol[i] = Wbuf[i * 64 + lane];
                    float Wc = 1.f;
#pragma unroll
                    for (int i = 0; i < 16; ++i) { Wc *= wcol[i]; Wbuf[i * 64 + lane] = Wc; }
                }
                asm volatile("" ::: "memory");
                f32x4 Wv[4], Wm[4], iWv[4];
#pragma unroll
                for (int q4 = 0; q4 < 4; ++q4) {
                    Wv[q4] = *(const f32x4*)(Wbuf + li * 64 + c16 + q4 * 4);
#pragma unroll
                    for (int e = 0; e < 4; ++e) {
                        iWv[q4][e] = __builtin_amdgcn_rcpf(Wv[q4][e]);
                        Wm[q4][e] = li > 0 ? Wv[q4][e] * __builtin_amdgcn_rcpf(wown[q4][e]) : 1.f;
                    }
                }
                asm volatile("" ::: "memory");
                {
                    bf16_t* KbT = (bf16_t*)(slot + SC_KBT); bf16_t* BbT = (bf16_t*)(slot + SC_BBT); bf16_t* VTs = (bf16_t*)(slot + SC_VT);
#pragma unroll
                    for (int hh = 0; hh < 2; ++hh) {
                        float okt[8], ort[8], okh[8], obh[8], rr[8], kx[8], kq[8], av[8];
                        unpack8(hh ? cr1 : cr0, rr); unpack8(hh ? ck1 : ck0, kx); unpack8(hh ? cq1 : cq0, kq); unpack8(hh ? ca1 : ca0, av);
#pragma unroll
                        for (int e = 0; e < 8; ++e) {
                            const int ce = hh * 8 + e, q4 = ce >> 2, qi = ce & 3;
                            const float kd = kx[e] * (1.f + (av[e] - 1.f) * ka16[ce]), bb = kq[e] * av[e];
                            okt[e] = kq[e] * Wm[q4][qi]; ort[e] = rr[e] * Wv[q4][qi];
                            okh[e] = kd * iWv[q4][qi]; obh[e] = bb * iWv[q4][qi];
                        }
                        *(u32x4*)(Kt + li * 72 + c16 + hh * 8) = pack8(okt); *(u32x4*)(Rt + li * 72 + c16 + hh * 8) = pack8(ort);
                        *(u32x4*)(Kh + li * 72 + c16 + hh * 8) = pack8(okh); *(u32x4*)(Bh + li * 72 + c16 + hh * 8) = pack8(obh);
                    }
                    *(u32x4*)(VTs + li * 64 + c16) = vraw0; *(u32x4*)(VTs + li * 64 + c16 + 8) = vraw1;
                    asm volatile("" ::: "memory");
                    const float WC = Wbuf[15 * 64 + lane];
                    float kcol[16], bcol[16]; unsigned vcol[16];
#pragma unroll
                    for (int i = 0; i < 16; ++i) { kcol[i] = bf2f(Kh[i * 72 + lane]) * WC; bcol[i] = bf2f(Bh[i * 72 + lane]) * WC; vcol[i] = VTs[i * 64 + lane]; }
                    asm volatile("" ::: "memory");
                    u32x4 t0, t1;
#pragma unroll
                    for (int e = 0; e < 4; ++e) { t0[e] = cvt_pk_bf16(kcol[2 * e], kcol[2 * e + 1]); t1[e] = cvt_pk_bf16(kcol[8 + 2 * e], kcol[8 + 2 * e + 1]); }
                    *(u32x4*)(KbT + lane * 16) = t0; *(u32x4*)(KbT + lane * 16 + 8) = t1;
#pragma unroll
                    for (int e = 0; e < 4; ++e) { t0[e] = cvt_pk_bf16(bcol[2 * e], bcol[2 * e + 1]); t1[e] = cvt_pk_bf16(bcol[8 + 2 * e], bcol[8 + 2 * e + 1]); }
                    *(u32x4*)(BbT + lane * 16) = t0; *(u32x4*)(BbT + lane * 16 + 8) = t1;
#pragma unroll
                    for (int e = 0; e < 4; ++e) { t0[e] = vcol[2 * e] | (vcol[2 * e + 1] << 16); t1[e] = vcol[8 + 2 * e] | (vcol[8 + 2 * e + 1] << 16); }
                    *(u32x4*)(VTs + lane * 16) = t0; *(u32x4*)(VTs + lane * 16 + 8) = t1;
                    ((float*)(slot + SC_WC))[lane] = WC;
                }
                asm volatile("" ::: "memory");
                if (gg + 1 < NGRP && rp2 == p.rep[14] - 1) SCAN_LOADRAW((gg + 1) * 4 + j);
                const bf16x8 ktx0 = *(const bf16x8*)(Kt + fr * 72 + fq * 8), ktx1 = *(const bf16x8*)(Kt + fr * 72 + 32 + fq * 8);
                const bf16x8 rtx0 = *(const bf16x8*)(Rt + fr * 72 + fq * 8), rtx1 = *(const bf16x8*)(Rt + fr * 72 + 32 + fq * 8);
                const bf16x8 khy0 = *(const bf16x8*)(Kh + fr * 72 + fq * 8), khy1 = *(const bf16x8*)(Kh + fr * 72 + 32 + fq * 8);
                const bf16x8 bhy0 = *(const bf16x8*)(Bh + fr * 72 + fq * 8), bhy1 = *(const bf16x8*)(Bh + fr * 72 + 32 + fq * 8);
                const f32x4 z4 = {0.f, 0.f, 0.f, 0.f};
                f32x4 A = MFMA16(ktx0, bhy0, z4); A = MFMA16(ktx1, bhy1, A);
                f32x4 Bm = MFMA16(ktx0, khy0, z4); Bm = MFMA16(ktx1, khy1, Bm);
                f32x4 E = MFMA16(rtx0, khy0, z4); E = MFMA16(rtx1, khy1, E);
                f32x4 F = MFMA16(rtx0, bhy0, z4); F = MFMA16(rtx1, bhy1, F);
                f32x4 I4, N;
#pragma unroll
                for (int jj = 0; jj < 4; ++jj) {
                    const int i = fq * 4 + jj;
                    I4[jj] = (i == fr) ? 1.f : 0.f;
                    N[jj] = (fr < i) ? -A[jj] : 0.f;
                    Bm[jj] = (fr < i) ? Bm[jj] : 0.f;
                    E[jj] = (fr <= i) ? E[jj] : 0.f;
                    F[jj] = (fr <= i) ? F[jj] : 0.f;
                }
                stD16(P1, I4 + N, fr, fq);
                f32x4 N2 = MFMA16(ldx4z(P1 + fr * 16 + fq * 4), pack4z(N), -N);
                stD16(P2, I4 + N2, fr, fq);
                f32x4 N4 = MFMA16(ldx4z(P2 + fr * 16 + fq * 4), pack4z(N2), -N2);
                stD16(P4, I4 + N4, fr, fq);
                f32x4 N8 = MFMA16(ldx4z(P4 + fr * 16 + fq * 4), pack4z(N4), -N4);
                f32x4 Tm = I4 + N8;
                Tm = MFMA16(ldx4z(P4 + fr * 16 + fq * 4), pack4z(Tm), z4);
                Tm = MFMA16(ldx4z(P2 + fr * 16 + fq * 4), pack4z(Tm), z4);
                Tm = MFMA16(ldx4z(P1 + fr * 16 + fq * 4), pack4z(Tm), z4);
                stD16((bf16_t*)(slot + SC_TM), Tm, fr, fq); stD16((bf16_t*)(slot + SC_BM), Bm, fr, fq);
                stD16((bf16_t*)(slot + SC_E), E, fr, fq); stD16((bf16_t*)(slot + SC_F), F, fr, fq);
            }
        }
        asm volatile("s_waitcnt lgkmcnt(0)" ::: "memory");
        __builtin_amdgcn_s_barrier();
        asm volatile("" ::: "memory");
      }
    } else {
#pragma unroll 1
      for (int g = -1; g < NGRP; ++g) {
        if (g >= 0 && wid < 4) {
#define CONS_LOAD(O, jj_) do { const unsigned char* sl_ = smem + ((g & 1) * 4 + (jj_)) * SC_SLOT; \
                _Pragma("unroll") for (int kt = 0; kt < 4; ++kt) { \
                    O.kt[kt] = *(const bf16x4*)((const bf16_t*)(sl_ + SC_KT) + fr * 72 + kt * 16 + fq * 4); O.rt[kt] = *(const bf16x4*)((const bf16_t*)(sl_ + SC_RT) + fr * 72 + kt * 16 + fq * 4); \
                    O.kb[kt] = *(const bf16x4*)((const bf16_t*)(sl_ + SC_KBT) + (kt * 16 + fr) * 16 + fq * 4); O.bb[kt] = *(const bf16x4*)((const bf16_t*)(sl_ + SC_BBT) + (kt * 16 + fr) * 16 + fq * 4); \
                    O.wc[kt] = *(const f32x4*)((const float*)(sl_ + SC_WC) + kt * 16 + fq * 4); } \
                O.bm = *(const bf16x4*)((const bf16_t*)(sl_ + SC_BM) + fr * 16 + fq * 4); O.e = *(const bf16x4*)((const bf16_t*)(sl_ + SC_E) + fr * 16 + fq * 4); \
                O.tm = *(const bf16x4*)((const bf16_t*)(sl_ + SC_TM) + fr * 16 + fq * 4); O.f = *(const bf16x4*)((const bf16_t*)(sl_ + SC_F) + fr * 16 + fq * 4); \
                O.vy = *(const bf16x4*)((const bf16_t*)(sl_ + SC_VT) + (cw * 32 + fr) * 16 + fq * 4); O.vy2 = *(const bf16x4*)((const bf16_t*)(sl_ + SC_VT) + (cw * 32 + 16 + fr) * 16 + fq * 4); } while (0)
#pragma unroll
            for (int j = 0; j < 4; ++j) {
                ConsOps cur;
                CONS_LOAD(cur, j);
                const int s0 = (g * 4 + j) * 16;
                const int row0 = s0 < 256 ? NLAT + b * 256 + (dir ? 255 - s0 : s0) : b * 4096 + (dir ? 4095 - (s0 - 256) : (s0 - 256));
                const f32x4 z4 = {0.f, 0.f, 0.f, 0.f};
#pragma unroll
                for (int vt = 0; vt < 2; ++vt) {
                    const bf16x8 VY = z8(vt ? cur.vy2 : cur.vy);
                    bf16x8 sb[4]; f32x4 tk[4];
#pragma unroll
                    for (int kt = 0; kt < 4; ++kt) sb[kt] = pack4z(st[vt][kt]);
                    f32x4 X1 = z4, Yo = z4;
#pragma unroll
                    for (int kt = 0; kt < 4; ++kt) X1 = MFMA16(z8(cur.kt[kt]), sb[kt], X1);
                    X1 = MFMA16(z8(cur.bm), VY, X1);
#pragma unroll
                    for (int kt = 0; kt < 4; ++kt) tk[kt] = MFMA16(z8(cur.kb[kt]), VY, st[vt][kt] * cur.wc[kt]);
#pragma unroll
                    for (int kt = 0; kt < 4; ++kt) Yo = MFMA16(z8(cur.rt[kt]), sb[kt], Yo);
                    Yo = MFMA16(z8(cur.e), VY, Yo);
                    const f32x4 U = MFMA16(z8(cur.tm), pack4z(X1), z4);
                    const bf16x8 nUb = pack4z(-U);
#pragma unroll
                    for (int kt = 0; kt < 4; ++kt) st[vt][kt] = MFMA16(z8(cur.bb[kt]), nUb, tk[kt]);
                    Yo = MFMA16(z8(cur.f), nUb, Yo);
#pragma unroll
                    for (int jj = 0; jj < 4; ++jj) {
                        const int row = row0 + (fq * 4 + jj) * rstep;
                        P[(size_t)row * LDP + OFF_RW + dir * 512 + h * 64 + (cw * 2 + vt) * 16 + fr] = f2bf(Yo[jj]);
                    }
                }
            }
#undef CONS_LOAD
        }
        asm volatile("s_waitcnt lgkmcnt(0)" ::: "memory");
        __builtin_amdgcn_s_barrier();
        asm volatile("" ::: "memory");
      }
    }
}

__device__ void phase_readout(const Params& p, int l, int nrows) {
    const int tid_ = otid(); const int lane = tid_ & 63, gw = blockIdx.x * 8 + (tid_ >> 6), nw = gridDim.x * 8;
    const bf16_t* RS = (const bf16_t*)(p.ws + O_H); const bf16_t* KS = RS + (size_t)NTOK * 512;
    const bf16_t* VS = (const bf16_t*)(p.ws + O_VS);
    const bf16_t* AA = (const bf16_t*)(p.ws + O_AA); const bf16_t* GG = (const bf16_t*)(p.ws + O_GG);
    bf16_t* P = (bf16_t*)(p.ws + O_P);
    const int c = lane * 8;
    float gng[8], gnb[8], rk[8], ka[8];
#pragma unroll
    for (int e = 0; e < 8; ++e) { gng[e] = p.in[18][l * 512 + c + e]; gnb[e] = p.in[19][l * 512 + c + e]; rk[e] = p.in[17][l * 512 + c + e]; ka[e] = p.in[16][l * 512 + c + e]; }
#define RO_LOAD(r, D) do { const bf16_t* pr_ = P + (size_t)(r) * LDP + OFF_RW; const size_t o_ = (size_t)(r) * 512 + c; \
        D[0] = *(const u32x4*)(pr_ + c); D[1] = *(const u32x4*)(pr_ + 512 + c); D[2] = *(const u32x4*)(RS + o_); D[3] = *(const u32x4*)(KS + o_); D[4] = *(const u32x4*)(VS + o_); \
        D[5] = *(const u32x4*)(AA + o_); D[6] = *(const u32x4*)(AA + (size_t)NTOK * 512 + o_); D[7] = *(const u32x4*)(GG + o_); } while (0)
    u32x4 nx[8];
    if (gw < nrows) RO_LOAD(gw, nx);
    for (int row = gw; row < nrows; row += nw) {
        bf16_t* pr = P + (size_t)row * LDP + OFF_RW;
        u32x4 cu[8];
#pragma unroll
        for (int i = 0; i < 8; ++i) cu[i] = nx[i];
        if (row + nw < nrows) RO_LOAD(row + nw, nx);
        float y0[8], y1[8], y[8];
        unpack8(cu[0], y0); unpack8(cu[1], y1);
        float s = 0.f;
#pragma unroll
        for (int e = 0; e < 8; ++e) { y[e] = y0[e] + y1[e]; s += y[e]; }
        s += __shfl_xor(s, 1); s += __shfl_xor(s, 2); s += __shfl_xor(s, 4);
        const float mu = s * (1.f / 64.f);
        float qv = 0.f;
#pragma unroll
        for (int e = 0; e < 8; ++e) { y[e] -= mu; qv += y[e] * y[e]; }
        qv += __shfl_xor(qv, 1); qv += __shfl_xor(qv, 2); qv += __shfl_xor(qv, 4);
        const float rs = rsqrtf(qv * (1.f / 64.f) + 64e-5f);
        float r[8], k[8], v[8], a0[8], a1[8], g[8];
        unpack8(cu[2], r); unpack8(cu[3], k); unpack8(cu[4], v);
        unpack8(cu[5], a0); unpack8(cu[6], a1); unpack8(cu[7], g);
        float bon = 0.f;
#pragma unroll
        for (int e = 0; e < 8; ++e) { const float kd = k[e] * (2.f + (a0[e] + a1[e] - 2.f) * ka[e]); bon += r[e] * kd * rk[e]; }
        bon += __shfl_xor(bon, 1); bon += __shfl_xor(bon, 2); bon += __shfl_xor(bon, 4);
        float ov[8];
#pragma unroll
        for (int e = 0; e < 8; ++e) ov[e] = (y[e] * rs * gng[e] + gnb[e] + bon * v[e]) * g[e];
        *(u32x4*)(pr + 1024 + c) = pack8(ov);
    }
}

template <bool CTX>
__device__ __forceinline__ void na_item_t(const Params& p, int l, int item, bool store, const float* rpbL) {
    const int tid = otid(); const int wid = tid >> 6, lane = tid & 63, fr = lane & 15, fq = lane >> 4;
    bf16_t* P = (bf16_t*)(p.ws + O_P);
    const bf16_t* VT = (const bf16_t*)(p.ws + O_VT);
    const int h = wid;
    int b, r = 0, j = 0, tq0, row0 = 0, ks0 = 0;
    if (!CTX) { b = item >> 8; r = (item >> 2) & 63; j = item & 3; tq0 = b * 4096 + r * 64 + j * 16; row0 = min(max(r - 4, 0), 56); ks0 = min(max(16 * j - 8, 0), 32); }
    else { b = item >> 4; tq0 = NLAT + b * 256 + (item & 15) * 16; }
    const bf16_t* qp = P + (size_t)(tq0 + fr) * LDP + OFF_Q + h * 64 + fq * 8;
    const bf16x8 bq0 = *(const bf16x8*)qp, bq1 = *(const bf16x8*)(qp + 32);
    f32x4 sc[32];
    const float* rpb = rpbL + h * 465;
    const int c = j * 16 + fr, kc0 = min(max(c - 8, 0), 48);
    constexpr int T0 = CTX ? 16 : 0;
    const f32x4 z4 = {0.f, 0.f, 0.f, 0.f};
    const int mperm = (fr >> 2) * 8 + (fr & 3);
#pragma unroll
    for (int tg = T0 / 8; tg < 4; ++tg) {
        bf16x8 kf[8][2];
#pragma unroll
        for (int t8 = 0; t8 < 8; ++t8) {
            const int t = tg * 8 + t8, tp = t >> 1, sfx = t & 1;
            const int tok = (tp < 8 ? b * 4096 + (row0 + tp) * 64 + ks0 : NLAT + b * 256 + (tp - 8) * 32) + mperm + sfx * 4;
            const bf16_t* kp = P + (size_t)tok * LDP + OFF_K + h * 64 + fq * 8;
            kf[t8][0] = *(const bf16x8*)kp; kf[t8][1] = *(const bf16x8*)(kp + 32);
        }
#pragma unroll
        for (int t8 = 0; t8 < 8; ++t8) {
            const int t = tg * 8 + t8, tp = t >> 1, sfx = t & 1;
            f32x4 a = MFMA16(kf[t8][0], bq0, z4); a = MFMA16(kf[t8][1], bq1, a);
            if (tp < 8) {
                const float* rp = rpb + (row0 + tp - r + 7) * 31;
#pragma unroll
                for (int jj = 0; jj < 4; ++jj) {
                    const int kc = ks0 + fq * 8 + sfx * 4 + jj;
                    const bool valid = kc >= kc0 && kc < kc0 + 16;
                    const float bias = rp[min(max(kc - c + 15, 0), 30)];
                    a[jj] = valid ? a[jj] * 0.125f + bias : -1e30f;
                }
            } else a = a * 0.125f;
            sc[t] = a;
        }
    }
    float mx = -1e30f;
#pragma unroll
    for (int t = T0; t < 32; ++t)
#pragma unroll
        for (int jj = 0; jj < 4; ++jj) mx = fmaxf(mx, sc[t][jj]);
    mx = fmaxf(mx, __shfl_xor(mx, 16)); mx = fmaxf(mx, __shfl_xor(mx, 32));
    float sum = 0.f;
#pragma unroll
    for (int t = T0; t < 32; ++t)
#pragma unroll
        for (int jj = 0; jj < 4; ++jj) { const float e = __expf(sc[t][jj] - mx); sc[t][jj] = e; sum += e; }
    sum += __shfl_xor(sum, 16); sum += __shfl_xor(sum, 32);
    f32x4 o[4];
#pragma unroll
    for (int dt = 0; dt < 4; ++dt) o[dt] = z4;
#pragma unroll
    for (int tpg = T0 / 8; tpg < 4; ++tpg) {
        bf16x8 vf[4][4];
#pragma unroll
        for (int t4 = 0; t4 < 4; ++t4) {
            const int tp = tpg * 4 + t4;
            const int base = (tp < 8 ? b * 4096 + (row0 + tp) * 64 + ks0 : NLAT + b * 256 + (tp - 8) * 32) + fq * 8;
#pragma unroll
            for (int dt = 0; dt < 4; ++dt) vf[t4][dt] = *(const bf16x8*)(VT + (size_t)(h * 64 + dt * 16 + fr) * NTOK + base);
        }
#pragma unroll
        for (int t4 = 0; t4 < 4; ++t4) {
            const int tp = tpg * 4 + t4;
            BF8 ap;
            ap.u[0] = cvt_pk_bf16(sc[2 * tp][0], sc[2 * tp][1]); ap.u[1] = cvt_pk_bf16(sc[2 * tp][2], sc[2 * tp][3]);
            ap.u[2] = cvt_pk_bf16(sc[2 * tp + 1][0], sc[2 * tp + 1][1]); ap.u[3] = cvt_pk_bf16(sc[2 * tp + 1][2], sc[2 * tp + 1][3]);
#pragma unroll
            for (int dt = 0; dt < 4; ++dt) o[dt] = MFMA16(ap.v, vf[t4][dt], o[dt]);
        }
    }
#pragma unroll
    for (int jj = 0; jj < 4; ++jj) {
        const float sj = __shfl(sum, fq * 4 + jj);
        const float inv = __builtin_amdgcn_rcpf(sj);
        bf16_t* op = P + (size_t)(tq0 + fq * 4 + jj) * LDP + OFF_Q + h * 64 + fr;
#pragma unroll
        for (int dt = 0; dt < 4; ++dt) if (store) op[dt * 16] = f2bf(o[dt][jj] * inv);
    }
}
__device__ void na_item(const Params& p, int l, int item, bool store, const float* rpbL) {
    if (item < 1024) na_item_t<false>(p, l, item, store, rpbL); else na_item_t<true>(p, l, item - 1024, store, rpbL);
}

constexpr int VLD = 136;
__device__ void sgu_item(const Params& p, int l, int chunk, unsigned char* smem, bool store) {
    const int tid = otid(), wid = tid >> 6, lane = tid & 63, fr = lane & 15, fq = lane >> 4;
    bf16_t* P = (bf16_t*)(p.ws + O_P);
    const bf16_t* SGW = (const bf16_t*)(p.ws + O_SGW) + (size_t)l * 8 * 128 * 128;
    float* stats = (float*)smem;
    bf16_t* VnT = (bf16_t*)(smem + 1024);
    const int rowb = chunk * 128;
    for (int i = 0; i < 16; ++i) {
        const int t = wid * 16 + i;
        float f[8]; unpack8(*(const u32x4*)(P + (size_t)(rowb + t) * LDP + OFF_SG + 512 + lane * 8), f);
        float s = 0.f;
#pragma unroll
        for (int e = 0; e < 8; ++e) { f[e] = gelu_tanh(f[e]); s += f[e]; }
#pragma unroll
        for (int o = 1; o < 64; o <<= 1) s += __shfl_xor(s, o);
        const float mu = s * (1.f / 512.f);
        float qv = 0.f;
#pragma unroll
        for (int e = 0; e < 8; ++e) { const float d = f[e] - mu; qv += d * d; }
#pragma unroll
        for (int o = 1; o < 64; o <<= 1) qv += __shfl_xor(qv, o);
        if (lane == 0) { stats[t * 2] = mu; stats[t * 2 + 1] = rsqrtf(qv * (1.f / 512.f) + 1e-5f); }
    }
    __syncthreads();
#pragma unroll 1
    for (int g = 0; g < 8; ++g) {
        {
            const int qq = tid >> 2, cg16 = (tid & 3) * 16;
            const float mu = stats[qq * 2], rs = stats[qq * 2 + 1];
            const bf16_t* vp = P + (size_t)(rowb + qq) * LDP + OFF_SG + 512 + g * 64 + cg16;
#pragma unroll
            for (int hh = 0; hh < 2; ++hh) {
                float f[8]; unpack8(*(const u32x4*)(vp + hh * 8), f);
#pragma unroll
                for (int e = 0; e < 8; ++e) {
                    const int cc = cg16 + hh * 8 + e;
                    const float val = (gelu_tanh(f[e]) - mu) * rs * p.in[20][l * 512 + g * 64 + cc] + p.in[21][l * 512 + g * 64 + cc];
                    VnT[cc * VLD + qq] = f2bf(val);
                }
            }
        }
        __syncthreads();
        {
            const int pp = wid * 16 + fr;
            const bf16_t* wp = SGW + ((size_t)g * 128 + pp) * 128 + fq * 8;
            bf16x8 wf[4];
#pragma unroll
            for (int ks = 0; ks < 4; ++ks) wf[ks] = *(const bf16x8*)(wp + ks * 32);
            const float bs = p.in[23][(l * 8 + g) * 128 + pp];
#pragma unroll
            for (int ct = 0; ct < 4; ++ct) {
                f32x4 acc = {0.f, 0.f, 0.f, 0.f};
#pragma unroll
                for (int ks = 0; ks < 4; ++ks) acc = __builtin_amdgcn_mfma_f32_16x16x32_bf16(*(const bf16x8*)(VnT + (ct * 16 + fr) * VLD + ks * 32 + fq * 8), wf[ks], acc, 0, 0, 0);
                bf16_t* up = P + (size_t)(rowb + pp) * LDP + OFF_SG + g * 64 + ct * 16 + fq * 4;
                float u[4]; unpack4(*(const u32x2*)up, u);
                u32x2 ov;
                ov[0] = cvt_pk_bf16(EN_SGU ? gelu_tanh(u[0]) * (acc[0] + bs) : 0.f, EN_SGU ? gelu_tanh(u[1]) * (acc[1] + bs) : 0.f);
                ov[1] = cvt_pk_bf16(EN_SGU ? gelu_tanh(u[2]) * (acc[2] + bs) : 0.f, EN_SGU ? gelu_tanh(u[3]) * (acc[3] + bs) : 0.f);
                if (store) *(u32x2*)up = ov;
            }
        }
        __syncthreads();
    }
}

#define XB_TMO      128
#define XB_XCNT(j)  (256  + 64 * (j))
#define XB_XSUB(j)  (1280 + 64 * (j))
#define XB_XGEN(j)  (2304 + 64 * (j))
#define XB_TOP      3328
#define XB_TOPGEN   3392
#define XCD_BAR_WORDS 3456
#define XB_SPIN_CAP (1u << 20)
__device__ __forceinline__ unsigned xb_ld(unsigned* p)              { return __hip_atomic_load(p, __ATOMIC_RELAXED, __HIP_MEMORY_SCOPE_AGENT); }
__device__ __forceinline__ unsigned xb_add(unsigned* p, unsigned v) { return __hip_atomic_fetch_add(p, v, __ATOMIC_RELAXED, __HIP_MEMORY_SCOPE_AGENT); }
__device__ __forceinline__ unsigned xb_xcc_id() { return (unsigned)__builtin_amdgcn_s_getreg((3 << 11) | 20) & 0xFu; }
#define XB_SPIN(cond, bar) do { unsigned _sp = 0; while (cond) { __builtin_amdgcn_s_sleep(1); \
    if ((++_sp & 255u) == 0u) { if (xb_ld(&(bar)[XB_TMO])) break; if (_sp > XB_SPIN_CAP) { atomicAdd(&(bar)[XB_TMO], 1u); break; } } } } while (0)
struct XcdBarrier { unsigned* bar; unsigned x; volatile LAS unsigned* st; };
__device__ __forceinline__ XcdBarrier xcd_barrier_post(unsigned* bar, volatile LAS unsigned* st) {
    XcdBarrier b; b.bar = bar; b.x = xb_xcc_id(); b.st = st;
    if (threadIdx.x == 0) (void)xb_add(&bar[XB_XCNT(b.x)], 1u);
    return b;
}
__device__ __forceinline__ void xcd_barrier_complete(unsigned* bar, unsigned x, unsigned& nloc, unsigned& nx) {
    const unsigned G = gridDim.x * gridDim.y * gridDim.z;
    unsigned sum, cnt, mine, sp = 0u;
    for (;;) {
        sum = 0u; cnt = 0u; mine = 0u;
#pragma unroll
        for (unsigned j = 0; j < 16; ++j) { const unsigned c = xb_ld(&bar[XB_XCNT(j)]); sum += c; cnt += (c > 0u) ? 1u : 0u; mine = (j == x) ? c : mine; }
        if (sum == G) break;
        __builtin_amdgcn_s_sleep(1);
        if ((++sp & 255u) == 0u) { if (xb_ld(&bar[XB_TMO])) break; if (sp > XB_SPIN_CAP) { atomicAdd(&bar[XB_TMO], 1u); break; } }
    }
    nloc = mine > 0u ? mine : 1u; nx = cnt > 0u ? cnt : 1u;
}
__device__ __attribute__((noinline)) void xcd_barrier(const XcdBarrier b) {
    asm volatile("s_waitcnt vmcnt(0)" ::: "memory");
    __syncthreads();
    if (threadIdx.x == 0) {
        unsigned* bar = b.bar;
        __builtin_amdgcn_s_waitcnt(0);
        unsigned nloc = b.st[0], nx = b.st[1];
        if (nloc == 0u) { xcd_barrier_complete(bar, b.x, nloc, nx); b.st[0] = nloc; b.st[1] = nx; }
        const unsigned old = xb_add(&bar[XB_XSUB(b.x)], 1u);
        const unsigned gen = old / nloc;
        if (old + 1u == (gen + 1u) * nloc) {
            __builtin_amdgcn_fence(__ATOMIC_RELEASE, "agent");
            asm volatile("s_waitcnt vmcnt(0)" ::: "memory");
            const unsigned og = xb_add(&bar[XB_TOP], 1u);
            const unsigned tg = og / nx;
            if (og + 1u == (tg + 1u) * nx) xb_add(&bar[XB_TOPGEN], 1u);
            else XB_SPIN(xb_ld(&bar[XB_TOPGEN]) == tg, bar);
            __builtin_amdgcn_fence(__ATOMIC_ACQUIRE, "agent");
            xb_add(&bar[XB_XGEN(b.x)], 1u);
            asm volatile("s_waitcnt vmcnt(0)" ::: "memory");
        } else {
            XB_SPIN(xb_ld(&bar[XB_XGEN(b.x)]) == gen, bar);
            __builtin_amdgcn_fence(__ATOMIC_ACQUIRE, "agent");
            asm volatile("s_waitcnt vmcnt(0)" ::: "memory");
        }
    }
    __syncthreads();
}

__global__ void __launch_bounds__(NTHR, 2) fwd_megakernel(Params p) {
    extern __shared__ __attribute__((aligned(16))) unsigned char smem[];
    cg::grid_group grid = cg::this_grid();
    const int G = gridDim.x, bid = blockIdx.x;
    float* ldsf = (float*)smem;
    LAS unsigned char* ldsg = (LAS unsigned char*)smem;
    bf16_t* H = (bf16_t*)(p.ws + O_H);
    bf16_t* P = (bf16_t*)(p.ws + O_P);
    const float* MOD = (const float*)(p.ws + O_MOD);

    unsigned* barw = (unsigned*)(p.ws + O_BAR);
    volatile LAS unsigned* bst = (volatile LAS unsigned*)(ldsg + 131072);
    if (bid == 0) for (int i = threadIdx.x; i < XCD_BAR_WORDS; i += NTHR) barw[i] = 0u;
    if (threadIdx.x < 2) bst[threadIdx.x] = 0u;
    __syncthreads();
    grid.sync();
    (void)xcd_barrier_post(barw, bst);
#define GRID_SYNC() do { XcdBarrier b_; b_.bar = (unsigned*)(p.ws + O_BAR); b_.x = xb_xcc_id(); b_.st = (volatile LAS unsigned*)((LAS unsigned char*)smem + 131072); xcd_barrier(b_); } while (0)
    if (bid < 96) phase_mod(p, ldsf, 0, 1, 0, 96);
    else for (int i = bid - 96; i < 1920 + 320; i += G - 96) { if (i < 1920) conv_win(p, 0, i, ldsf); else conv_small(p, i - 1920, ldsf); }
    GRID_SYNC();
    phase_rows(p, 0, 0, NTOK, true);
    GRID_SYNC();

#pragma unroll 1
    for (int l = 0; l < NL; ++l) {
        const bool lastl = (l == NL - 1);
        const int nMrows = lastl ? NLAT / BM : NTOK / BM;
        const int nrows = lastl ? NLAT : NTOK;
        for (int rp = 0; rp < p.rep[0]; ++rp) {
            GemmDesc g; g.A0 = g.A1 = g.A2 = H; g.B0 = g.B1 = g.B2 = (const bf16_t*)(p.ws + O_WIN); g.lda = DM; g.K = DM;
            TileOrder S; S.init(NTOK / BM, DINP / BM, G, bid, 1);
            EpiP E; E.P = P; E.VT = (bf16_t*)(p.ws + O_VT);
            gemm_phase(ldsg, g, S, E);
        }
        GRID_SYNC();
        for (int rp = 1; rp < p.rep[13]; ++rp) GRID_SYNC();
        for (int rp = 0; rp < p.rep[1]; ++rp) phase_prep(p, l, smem);
        GRID_SYNC();
        if (bid < 64) {
            for (int rp = 0; rp < p.rep[2]; ++rp) scan_chain(p, l, bid, smem);
        } else {
            const int nsgu = lastl ? NLAT / 128 : NTOK / 128;
            const int nna = lastl ? 1024 : 1088;
            for (int rp = 0; rp < p.rep[3]; ++rp)
                for (int i = bid - 64; i < nsgu; i += G - 64) sgu_item(p, l, i, smem, rp == p.rep[3] - 1);
            float* rpbL = ldsf + 8192;
            for (int i = otid(); i < 8 * 465; i += NTHR) rpbL[i] = p.in[7][(size_t)l * 8 * 465 + i];
            __syncthreads();
            for (int rp = 0; rp < p.rep[4]; ++rp)
                for (int i = bid - 64; i < nna; i += G - 64) na_item(p, l, i, rp == p.rep[4] - 1, rpbL);
            __syncthreads();
            if (l == 0) for (int ci = bid - 64; ci < NCONV_LAYER; ci += G - 64) conv_layer(p, 0, ci, ldsf);
        }
        GRID_SYNC();
        for (int rp = 0; rp < p.rep[6]; ++rp) phase_readout(p, l, nrows);
        GRID_SYNC();
        for (int rp = 0; rp < p.rep[7]; ++rp) {
            GemmDesc g; g.A0 = P + OFF_Q; g.A1 = P + OFF_RW + 1024; g.A2 = P + OFF_SG;
            const bf16_t* wb = (const bf16_t*)(p.ws + O_WB); g.B0 = wb; g.B1 = wb + (size_t)DM * 512; g.B2 = wb + (size_t)2 * DM * 512; g.lda = LDP; g.K = 512;
            TileOrder S; S.init(nMrows, DM / BM, G, bid, 3);
            EpiMerge E; E.P = P; E.Y = H;
            gemm_phase(ldsg, g, S, E);
        }
        GRID_SYNC();
        for (int rp = 0; rp < p.rep[8]; ++rp) {
            GemmDesc g; g.A0 = g.A1 = g.A2 = H; g.B0 = g.B1 = g.B2 = (const bf16_t*)(p.ws + O_WOUT); g.lda = DM; g.K = DM;
            TileOrder S; S.init(nMrows, DM / BM, G, bid, 1);
            EpiRes E; E.p = p; E.mod = MOD + (size_t)l * 5 * 6144; E.gidx = 2; E.store = (rp == p.rep[8] - 1);
            gemm_phase(ldsg, g, S, E);
        }
        GRID_SYNC();
        for (int rp = 0; rp < p.rep[9]; ++rp) phase_rows(p, 1, l, nrows, rp == p.rep[9] - 1);
        GRID_SYNC();
        for (int rp = 0; rp < p.rep[10]; ++rp) {
            GemmDesc g; g.A0 = g.A1 = g.A2 = H; g.B0 = g.B1 = g.B2 = (const bf16_t*)(p.ws + O_WGU); g.lda = DM; g.K = DM;
            TileOrder S; S.init(nMrows, 2 * DFF / BM, G, bid, 1);
            EpiGlu E; E.HID = P;
            gemm_phase(ldsg, g, S, E);
        }
        GRID_SYNC();
        for (int rp = 0; rp < p.rep[11]; ++rp) {
            GemmDesc g; g.A0 = g.A1 = g.A2 = P; g.B0 = g.B1 = g.B2 = (const bf16_t*)(p.ws + O_WDN) + (size_t)(l & 1) * DM * DFF; g.lda = DFF; g.K = DFF;
            TileOrder S; S.init(nMrows, DM / BM, G, bid, 1);
            EpiRes E; E.p = p; E.mod = MOD + (size_t)l * 5 * 6144; E.gidx = 5; E.store = (rp == p.rep[11] - 1);
            gemm_phase(ldsg, g, S, E);
        }
        if (!lastl && bid >= 16) {
            if (bid < 112) phase_mod(p, ldsf, l + 1, 1, 16, 96);
            else for (int rp = 0; rp < p.rep[5]; ++rp)
                for (int ci = bid - 112; ci < NCONV_LAYER + 1920; ci += G - 112) { if (ci < NCONV_LAYER) conv_layer(p, l + 1, ci, ldsf); else conv_win(p, l + 1, ci - NCONV_LAYER, ldsf); }
        }
        GRID_SYNC();
        for (int rp = 0; rp < p.rep[12]; ++rp) phase_rows(p, 2, l, nrows, rp == p.rep[12] - 1);
        GRID_SYNC();
    }
}

extern "C" void kernel_launch(void* const* d_in, const int* in_sizes, int n_in, void* d_out, int out_size, void* d_ws, size_t ws_size, hipStream_t stream) {
    static int grid_blocks = 0;
    if (!grid_blocks) {
        int dev = 0, cus = 0, per_cu = 0;
        hipGetDevice(&dev);
        hipDeviceGetAttribute(&cus, hipDeviceAttributeMultiprocessorCount, dev);
        hipFuncSetAttribute((const void*)fwd_megakernel, hipFuncAttributeMaxDynamicSharedMemorySize, SMEM_BYTES);
        hipOccupancyMaxActiveBlocksPerMultiprocessor(&per_cu, fwd_megakernel, NTHR, SMEM_BYTES);
        if (per_cu < 1) per_cu = 1;
        if (per_cu > 1) per_cu = 1;
        grid_blocks = cus * per_cu;
    }
    if (ws_size < WS_TOTAL) { fprintf(stderr, "workspace too small: %zu < %zu\n", ws_size, (size_t)WS_TOTAL); return; }
    Params p{};
    for (int i = 0; i < 32; ++i) p.in[i] = (const float*)d_in[i];
    p.out = (float*)d_out;
    p.ws = (unsigned char*)d_ws;
    for (int i = 0; i < 16; ++i) p.rep[i] = 1;
#ifdef REPK
    p.rep[REPK] = 2;
#endif
    void* args[] = {&p};
    hipError_t e = hipLaunchCooperativeKernel((void*)fwd_megakernel, dim3(grid_blocks), dim3(NTHR), args, SMEM_BYTES, stream);
    if (e != hipSuccess) fprintf(stderr, "cooperative launch failed: %s (grid %d)\n", hipGetErrorString(e), grid_blocks);
}
```
